# Optimizing an MI355X kernel written in HIP

```python
import jax, jax.numpy as jnp
from jax import lax
import numpy as np

D_MODEL = 1024
BATCH = 4
SEQ = 4096
DEPTH = 1

D_RNN = D_MODEL
N_RNN_BLOCKS = 4
RNN_BLOCK = D_RNN // N_RNN_BLOCKS
CONV_WIDTH = 4
C_RG = 8.0
MIN_RAD, MAX_RAD = 0.9, 0.999
D_POOL = D_MODEL
POOL_WINDOWS = (2, 4, 8, 16)
N_POOL_GROUPS = len(POOL_WINDOWS)
POOL_GROUP = D_POOL // N_POOL_GROUPS
N_BRANCHES = 2
D_FF = 4 * D_MODEL
N_MOD = 6
D_IN = 2 * D_RNN + D_POOL + N_BRANCHES * D_MODEL
EPS = 1e-6

kernel_name = "hybrid_rglru_pool_gated_block"


def rmsnorm(x, g):
    xf = x.astype(jnp.float32)
    y = xf * lax.rsqrt(jnp.mean(xf * xf, axis=-1, keepdims=True) + EPS)
    return (y * g.astype(jnp.float32)).astype(x.dtype)


def block_diag(x, w):
    b, s, _ = x.shape
    g, dg, _ = w.shape
    y = jnp.einsum('bsgi,gij->bsgj', x.reshape(b, s, g, dg), w)
    return y.reshape(b, s, g * dg)


def causal_conv(x, w, bias):
    k = w.shape[0]
    s = x.shape[1]
    xp = jnp.pad(x, ((0, 0), (k - 1, 0), (0, 0)))
    y = bias
    for j in range(k):
        y = y + xp[:, j:j + s] * w[j]
    return y


def rg_lru(x, w_a, b_a, w_x, b_x, a_param):
    xf = x.astype(jnp.float32)
    r = jax.nn.sigmoid(block_diag(xf, w_a.astype(jnp.float32)) + b_a.astype(jnp.float32))
    i = jax.nn.sigmoid(block_diag(xf, w_x.astype(jnp.float32)) + b_x.astype(jnp.float32))
    log_a = -C_RG * r * jax.nn.softplus(a_param.astype(jnp.float32))
    a = jnp.exp(log_a)
    mult = jnp.sqrt(-jnp.expm1(2.0 * log_a))
    first = (jnp.arange(x.shape[1]) == 0)[None, :, None]
    mult = jnp.where(first, 1.0, mult)
    bval = xf * i * mult

    def combine(l, rr):
        a1, b1 = l
        a2, b2 = rr
        return a1 * a2, a2 * b1 + b2

    _, h = lax.associative_scan(combine, (a, bval), axis=1)
    return h.astype(x.dtype)


def multiscale_pool(u, w_pool, b_pool, pool_scale):
    uf = u.astype(jnp.float32)
    s = u.shape[1]
    pos = jnp.arange(s, dtype=jnp.float32)[None, :, None]
    outs = []
    for gi, win in enumerate(POOL_WINDOWS):
        seg = uf[..., gi * POOL_GROUP:(gi + 1) * POOL_GROUP]
        cs = jnp.cumsum(seg, axis=1)
        cs_prev = jnp.pad(cs, ((0, 0), (win, 0), (0, 0)))[:, :s]
        cnt = jnp.minimum(pos + 1.0, float(win))
        outs.append((cs - cs_prev) / cnt - seg)
    p = jnp.concatenate(outs, axis=-1)
    p = block_diag(p, w_pool.astype(jnp.float32)) + b_pool.astype(jnp.float32)
    return (p * pool_scale.astype(jnp.float32)).astype(u.dtype)


def setup_inputs(seed: int = 0) -> dict:
    key = jax.random.key(seed)
    ks = jax.random.split(key, 24)
    f32 = jnp.float32
    L = DEPTH

    def nrm(k, shape, fan_in):
        return jax.random.normal(k, shape, f32) * (fan_in ** -0.5)

    u = jax.random.uniform(ks[10], (L, D_RNN), f32)
    a_real = 0.5 * jnp.log(u * (MAX_RAD ** 2 - MIN_RAD ** 2) + MIN_RAD ** 2)
    a_param = jnp.log(jnp.expm1(-a_real))
    return {
        "x": jax.random.normal(ks[0], (BATCH, SEQ, D_MODEL), f32),
        "c": jax.random.normal(ks[1], (BATCH, D_MODEL), f32),
        "norm_mix_g": 1.0 + 0.05 * jax.random.normal(ks[2], (L, D_MODEL), f32),
        "norm_mlp_g": 1.0 + 0.05 * jax.random.normal(ks[3], (L, D_MODEL), f32),
        "w_ada": nrm(ks[4], (L, D_MODEL, N_MOD * D_MODEL), D_MODEL),
        "b_ada": 0.02 * jax.random.normal(ks[5], (L, N_MOD * D_MODEL), f32),
        "w_in": nrm(ks[6], (L, D_MODEL, D_IN), D_MODEL),
        "conv_w": nrm(ks[7], (L, CONV_WIDTH, D_RNN), CONV_WIDTH),
        "conv_b": 0.02 * jax.random.normal(ks[8], (L, D_RNN), f32),
        "w_rg_a": nrm(ks[9], (L, N_RNN_BLOCKS, RNN_BLOCK, RNN_BLOCK), RNN_BLOCK),
        "b_rg_a": 0.02 * jax.random.normal(ks[11], (L, D_RNN), f32),
        "w_rg_x": nrm(ks[12], (L, N_RNN_BLOCKS, RNN_BLOCK, RNN_BLOCK), RNN_BLOCK),
        "b_rg_x": 0.02 * jax.random.normal(ks[13], (L, D_RNN), f32),
        "a_param": a_param,
        "w_branch_a": nrm(ks[14], (L, D_RNN, D_MODEL), D_RNN),
        "w_pool": nrm(ks[15], (L, N_POOL_GROUPS, POOL_GROUP, POOL_GROUP), POOL_GROUP),
        "b_pool": 0.02 * jax.random.normal(ks[16], (L, D_POOL), f32),
        "pool_scale": 1.0 + 0.1 * jax.random.normal(ks[17], (L, D_POOL), f32),
        "w_branch_b": nrm(ks[18], (L, D_POOL, D_MODEL), D_POOL),
        "w_out": nrm(ks[19], (L, D_MODEL, D_MODEL), D_MODEL),
        "w_up": nrm(ks[20], (L, D_MODEL, D_FF), D_MODEL),
        "w_down": nrm(ks[21], (L, D_FF, D_MODEL), D_FF),
        "final_g": 1.0 + 0.05 * jax.random.normal(ks[22], (D_MODEL,), f32),
    }


def reference(x, c, norm_mix_g, norm_mlp_g, w_ada, b_ada, w_in, conv_w, conv_b,
              w_rg_a, b_rg_a, w_rg_x, b_rg_x, a_param, w_branch_a, w_pool, b_pool,
              pool_scale, w_branch_b, w_out, w_up, w_down, final_g):
    c_act = jax.nn.silu(c)
    for l in range(DEPTH):
        mod = c_act @ w_ada[l] + b_ada[l]
        sh1, sc1, gt1, sh2, sc2, gt2 = [m[:, None, :] for m in jnp.split(mod, N_MOD, axis=-1)]

        h = rmsnorm(x, norm_mix_g[l]) * (1.0 + sc1) + sh1
        proj = h @ w_in[l]
        x_rnn, y_rnn, u_pool, g_a, g_b = jnp.split(
            proj, np.cumsum([D_RNN, D_RNN, D_POOL, D_MODEL]).tolist(), axis=-1)

        xr = causal_conv(x_rnn, conv_w[l], conv_b[l])
        hr = rg_lru(xr, w_rg_a[l], b_rg_a[l], w_rg_x[l], b_rg_x[l], a_param[l])
        branch_a = (jax.nn.gelu(y_rnn) * hr) @ w_branch_a[l]

        pooled = multiscale_pool(u_pool, w_pool[l], b_pool[l], pool_scale[l])
        branch_b = pooled @ w_branch_b[l]

        merged = jax.nn.sigmoid(g_a) * branch_a + jax.nn.sigmoid(g_b) * branch_b
        x = x + gt1 * (merged @ w_out[l])

        h = rmsnorm(x, norm_mlp_g[l]) * (1.0 + sc2) + sh2
        ff = jnp.square(jax.nn.relu(h @ w_up[l]))
        x = x + gt2 * (ff @ w_down[l])
    return rmsnorm(x, final_g)
```

```cpp
#include <hip/hip_runtime.h>
#include <cstdio>
#include <cstdint>

#define GAS __attribute__((address_space(1)))
#define LAS __attribute__((address_space(3)))
typedef unsigned short bf16_t;
typedef short bf16x8 __attribute__((ext_vector_type(8)));
typedef float f32x4 __attribute__((ext_vector_type(4)));
typedef float f32x2 __attribute__((ext_vector_type(2)));
typedef unsigned u32x4 __attribute__((ext_vector_type(4)));
typedef unsigned u32x2 __attribute__((ext_vector_type(2)));
typedef GAS unsigned gu32;

constexpr int NWAVES = 8;
constexpr int BATCH = 4, SEQ = 4096, D = 1024, DIN = 5120, FF = 4096, NMOD = 6144;
constexpr int M = BATCH * SEQ;
constexpr float EPS = 1e-6f;

constexpr size_t MiB = 1u << 20;
constexpr size_t WS_CTL = 0, CTL_ZERO_BYTES = 1 * MiB;
constexpr size_t WS_MODP = 1 * MiB;
constexpr size_t WS_MODF = 1 * MiB + 256 * 1024;
constexpr size_t WS_SPT = 1 * MiB + 512 * 1024;
constexpr size_t WS_WIN = 2 * MiB;
constexpr size_t WS_WA = 12 * MiB, WS_WB = 14 * MiB, WS_WO = 16 * MiB;
constexpr size_t WS_WUP = 18 * MiB;
constexpr size_t WS_WDN = 26 * MiB;
constexpr size_t WS_WG = 34 * MiB;
constexpr size_t WS_H = 36 * MiB;
constexpr size_t WS_X = 68 * MiB, WS_Y = 100 * MiB, WS_V = 132 * MiB, WS_GA = 164 * MiB, WS_GB = 196 * MiB;
constexpr size_t WS_FF = 68 * MiB;
constexpr size_t WS_END = 228 * MiB;
constexpr int CW_BAR = 4096;

constexpr int RING_BYTES = 131072;
constexpr int LDSCTL_OFF = 143360, MISC_OFF = LDSCTL_OFF + 320;
constexpr int LDS_BYTES = 147456;

#define LDS_WAIT() asm volatile("s_waitcnt lgkmcnt(0)" ::: "memory")
#define VM_WAIT() asm volatile("s_waitcnt vmcnt(0)" ::: "memory")
__device__ __forceinline__ unsigned f2bf(float f) { unsigned u = __builtin_bit_cast(unsigned, f); return (u + 0x7fffu + ((u >> 16) & 1u)) >> 16; }
__device__ __forceinline__ unsigned pk2(float lo, float hi) { return f2bf(lo) | (f2bf(hi) << 16); }
__device__ __forceinline__ float bflo(unsigned u) { return __uint_as_float(u << 16); }
__device__ __forceinline__ float bfhi(unsigned u) { return __uint_as_float(u & 0xffff0000u); }
__device__ __forceinline__ float bf1(bf16_t h) { return __uint_as_float((unsigned)h << 16); }
__device__ __forceinline__ unsigned cvt_pk_bf16(float lo, float hi) { unsigned r; asm volatile("v_cvt_pk_bf16_f32 %0, %1, %2" : "=v"(r) : "v"(lo), "v"(hi)); return r; }
__device__ __forceinline__ float fast_exp(float x) { return __builtin_amdgcn_exp2f(x * 1.44269504089f); }
__device__ __forceinline__ float sigmoidf_(float x) { return __builtin_amdgcn_rcpf(1.0f + fast_exp(-x)); }
__device__ __forceinline__ float gelu_tanh(float y) { const float u = y * (1.0f + 0.044715f * y * y); return y * __builtin_amdgcn_rcpf(1.0f + fast_exp(-1.5957691216f * u)); }
__device__ __forceinline__ float wave_sum(float v) {
#pragma unroll
    for (int o = 1; o < 64; o <<= 1) v += __shfl_xor(v, o);
    return v;
}

__device__ __forceinline__ int tid_from_wave(int wave_s) { int l; asm volatile("v_mbcnt_lo_u32_b32 %0, -1, 0\n\tv_mbcnt_hi_u32_b32 %0, -1, %0" : "=v"(l)); return wave_s * 64 + l; }
#define XB_TMO      128
#define XB_XCNT(j)  (256  + 64 * (j))
#define XB_XSUB(j)  (1280 + 64 * (j))
#define XB_XGEN(j)  (2304 + 64 * (j))
#define XB_TOP      3328
#define XB_TOPGEN   3392
#define XCD_BAR_WORDS 3456
#define XB_SPIN_CAP (1u << 18)
__device__ __forceinline__ unsigned xb_ld(unsigned* p)              { return __hip_atomic_load(p, __ATOMIC_RELAXED, __HIP_MEMORY_SCOPE_AGENT); }
__device__ __forceinline__ unsigned xb_add(unsigned* p, unsigned v) { return __hip_atomic_fetch_add(p, v, __ATOMIC_RELAXED, __HIP_MEMORY_SCOPE_AGENT); }
__device__ __forceinline__ unsigned xb_xcc_id() { return (unsigned)__builtin_amdgcn_s_getreg((3 << 11) | 20) & 0xFu; }
#define XB_SPIN(cond, bar) do { unsigned _sp = 0; while (cond) { __builtin_amdgcn_s_sleep(1); \
    if ((++_sp & 255u) == 0u) { if (xb_ld(&(bar)[XB_TMO])) break; if (_sp > XB_SPIN_CAP) { atomicAdd(&(bar)[XB_TMO], 1u); break; } } } } while (0)
struct XcdBarrier { unsigned* bar; unsigned x; volatile LAS unsigned* st; };
__device__ __forceinline__ XcdBarrier xcd_barrier_post(unsigned* bar, volatile LAS unsigned* st) {
    XcdBarrier b; b.bar = bar; b.x = xb_xcc_id(); b.st = st;
    if (threadIdx.x == 0) (void)xb_add(&bar[XB_XCNT(b.x)], 1u);
    return b;
}
__device__ __forceinline__ void xcd_barrier_complete(unsigned* bar, unsigned x, unsigned& nloc, unsigned& nx) {
    const unsigned G = gridDim.x * gridDim.y * gridDim.z;
    unsigned sum, cnt, mine, sp = 0u;
    for (;;) {
        sum = 0u; cnt = 0u; mine = 0u;
#pragma unroll
        for (unsigned j = 0; j < 16; ++j) { const unsigned c = xb_ld(&bar[XB_XCNT(j)]); sum += c; cnt += (c > 0u) ? 1u : 0u; mine = (j == x) ? c : mine; }
        if (sum == G) break;
        __builtin_amdgcn_s_sleep(1);
        if ((++sp & 255u) == 0u) { if (xb_ld(&bar[XB_TMO])) break; if (sp > XB_SPIN_CAP) { atomicAdd(&bar[XB_TMO], 1u); break; } }
    }
    nloc = mine > 0u ? mine : 1u; nx = cnt > 0u ? cnt : 1u;
}
__device__ __forceinline__ void xcd_barrier(const XcdBarrier& b) {
    asm volatile("s_waitcnt vmcnt(0)" ::: "memory");
    __syncthreads();
    if (threadIdx.x == 0) {
        unsigned* bar = b.bar;
        __builtin_amdgcn_s_waitcnt(0);
        unsigned nloc = b.st[0], nx = b.st[1];
        if (nloc == 0u) { xcd_barrier_complete(bar, b.x, nloc, nx); b.st[0] = nloc; b.st[1] = nx; }
        const unsigned old = xb_add(&bar[XB_XSUB(b.x)], 1u);
        const unsigned gen = old / nloc;
        if (old + 1u == (gen + 1u) * nloc) {
            __builtin_amdgcn_fence(__ATOMIC_RELEASE, "agent");
            asm volatile("s_waitcnt vmcnt(0)" ::: "memory");
            const unsigned og = xb_add(&bar[XB_TOP], 1u);
            const unsigned tg = og / nx;
            if (og + 1u == (tg + 1u) * nx) xb_add(&bar[XB_TOPGEN], 1u);
            else XB_SPIN(xb_ld(&bar[XB_TOPGEN]) == tg, bar);
            __builtin_amdgcn_fence(__ATOMIC_ACQUIRE, "agent");
            xb_add(&bar[XB_XGEN(b.x)], 1u);
            asm volatile("s_waitcnt vmcnt(0)" ::: "memory");
        } else {
            XB_SPIN(xb_ld(&bar[XB_XGEN(b.x)]) == gen, bar);
            __builtin_amdgcn_fence(__ATOMIC_ACQUIRE, "agent");
            asm volatile("s_waitcnt vmcnt(0)" ::: "memory");
        }
    }
    __syncthreads();
}

namespace pg8 {
constexpr int BM = 256, BK = 64, HALF = 128, HTB = HALF * BK * 2, NXCD = 8, WGM = 8;
__host__ __device__ __forceinline__ int lds_byte(int r, int c) { const int st = (r >> 4) * 2 + (c >> 5), rr = r & 15, cc = c & 31, ob = rr * 64 + cc * 2; return st * 1024 + (ob ^ (((ob >> 9) & 1) << 5)); }
__host__ __device__ __forceinline__ void stage_rc(int b, int& R, int& C) { const int st = b / 1024, sb = b % 1024, swz = sb ^ (((sb >> 9) & 1) << 5); R = (st >> 1) * 16 + swz / 64; C = (st & 1) * 32 + (swz % 64) / 2; }
__host__ __device__ __forceinline__ int perm32(int rho) { const int n = rho >> 4, i = rho & 15; return 8 * (i >> 2) + 4 * n + (i & 3); }

struct Unit { int pm, pn, seg; };
__device__ __forceinline__ bool tile_of(int L, int nM, int nN, Unit& u) {
    const int nwg = nM * nN; if (L >= nwg) return false;
    int wgid = L; { const int q = nwg / NXCD, r = nwg % NXCD, xcd = wgid % NXCD, off = wgid / NXCD; wgid = (xcd < r ? xcd * (q + 1) : r * (q + 1) + (xcd - r) * q) + off; }
    const int nig = WGM * nN, gid = wgid / nig, fm = gid * WGM, gsz = (nM - fm) < WGM ? (nM - fm) : WGM;
    u.pm = fm + ((wgid % nig) % gsz); u.pn = (wgid % nig) / gsz; return true;
}
struct Sched {
    int nM, nN, G, c, nseg;
    const char* A[2]; const char* B[2];
    int lda, ldb;
    int acol_mul, acol_shift;
    int arow_all;
    __device__ __forceinline__ bool next(int i, Unit& u) const {
        const int ti = i / nseg; u.seg = i - ti * nseg;
        return tile_of(ti * G + c, nM, nN, u);
    }
    __device__ __forceinline__ const char* aptr(const Unit& u) const { return (u.seg ? A[1] : A[0]) + ((size_t)u.pm * BM * lda + (size_t)acol_mul * (u.pn >> acol_shift)) * 2; }
    __device__ __forceinline__ const char* bptr(const Unit& u) const { return (u.seg ? B[1] : B[0]) + ((size_t)u.pn * BM * ldb) * 2; }
};

template <class Epi, bool ALIGN_EPI, bool SP2>
__device__ __forceinline__ void gemm_phase(LAS unsigned char* lds, const Sched& S, int K, const Epi& E, int wave_s) {
    const int tid = tid_from_wave(wave_s), wid = wave_s, lane = tid & 63, wr = wid >> 2, wc = wid & 3, fr = lane & 15, fq = lane >> 4;
    const int nt = K / BK;
    unsigned voffA[2], voffB[2];
#pragma unroll
    for (int i = 0; i < 2; ++i) { int R, C; stage_rc(tid * 16 + i * 8192, R, C); const int Rb = Epi::PERM ? ((R & ~31) + perm32(R & 31)) : R;
        voffA[i] = (unsigned)(R * S.lda + C) * 2u; voffB[i] = (unsigned)(Rb * S.ldb + C) * 2u; }
    const size_t kstep = (size_t)(BK * 2);
    const size_t hstepA = (size_t)HALF * S.lda * 2, hstepB = (size_t)HALF * S.ldb * 2;
    const unsigned ldsw = (unsigned)wid * 1024u;
    const int aoff = lds_byte(wr * 64 + fr, fq * 8), boff = lds_byte(wc * 32 + fr, fq * 8);
#define PG8_SA(b, h) (((b) * 2 + (h)) * HTB)
#define PG8_SB(b, h) ((4 + (b) * 2 + (h)) * HTB)
#define PG8_STAGE(bufoff, gbase, voff) do { _Pragma("unroll") for (int _i = 0; _i < 2; ++_i) \
        __builtin_amdgcn_global_load_lds((const unsigned*)((const char*)(gbase) + (voff)[_i]), (LAS unsigned*)(lds + (bufoff) + ldsw + _i * 8192), 16, 0, 0); } while (0)
#define PG8_LDA(dst, b, h) do { _Pragma("unroll") for (int m = 0; m < 4; ++m) _Pragma("unroll") for (int k = 0; k < 2; ++k) dst[m][k] = *(const LAS bf16x8*)(lds + PG8_SA(b, h) + aoff + m * 2048 + k * 1024); } while (0)
#define PG8_LDB(dst, b, h) do { _Pragma("unroll") for (int n = 0; n < 2; ++n) _Pragma("unroll") for (int k = 0; k < 2; ++k) dst[n][k] = *(const LAS bf16x8*)(lds + PG8_SB(b, h) + boff + n * 2048 + k * 1024); } while (0)
#define PG8_MMA(ai, bj, At, Bt) do { __builtin_amdgcn_s_setprio(1); _Pragma("unroll") for (int m = 0; m < 4; ++m) _Pragma("unroll") for (int n = 0; n < 2; ++n) _Pragma("unroll") for (int k = 0; k < 2; ++k) \
        acc[ai][bj][m][n] = __builtin_amdgcn_mfma_f32_16x16x32_bf16(Bt[n][k], At[m][k], acc[ai][bj][m][n], 0, 0, 0); __builtin_amdgcn_s_setprio(0); } while (0)
#define PG8_WAIT_V(n) asm volatile("s_waitcnt vmcnt(" #n ")" ::: "memory")
#define PG8_WAIT_L(n) asm volatile("s_waitcnt lgkmcnt(" #n ")" ::: "memory")
#define PG8_BAR __builtin_amdgcn_s_barrier()
#define PG8_SCHED __builtin_amdgcn_sched_barrier(0)
    Unit cur, nxt; int ui = 0;
    if (!S.next(0, cur)) return;
    f32x4 acc[2][2][4][2];
#pragma unroll
    for (int a = 0; a < 2; ++a)
#pragma unroll
        for (int b = 0; b < 2; ++b)
#pragma unroll
            for (int m = 0; m < 4; ++m)
#pragma unroll
                for (int n = 0; n < 2; ++n) acc[a][b][m][n] = (f32x4){0.f, 0.f, 0.f, 0.f};
    bf16x8 At[4][2], B0[2][2], B1[2][2];
    const char* cA = S.aptr(cur); const char* cB = S.bptr(cur);
    if constexpr (SP2) {
        PG8_STAGE(PG8_SB(0, 0), cB, voffB); PG8_STAGE(PG8_SB(0, 1), cB + hstepB, voffB); PG8_STAGE(PG8_SA(0, 0), cA, voffA); PG8_STAGE(PG8_SA(0, 1), cA + hstepA, voffA);
        if (wr == 1) PG8_BAR;
        PG8_WAIT_V(2); PG8_BAR;
        PG8_STAGE(PG8_SB(1, 0), cB + kstep, voffB); PG8_STAGE(PG8_SA(1, 0), cA + kstep, voffA); PG8_STAGE(PG8_SB(1, 1), cB + hstepB + kstep, voffB);
        PG8_WAIT_V(6); PG8_BAR;
    } else {
        PG8_STAGE(PG8_SB(0, 0), cB, voffB); PG8_STAGE(PG8_SA(0, 0), cA, voffA); PG8_STAGE(PG8_SB(0, 1), cB + hstepB, voffB); PG8_STAGE(PG8_SA(0, 1), cA + hstepA, voffA);
        if (wr == 1) PG8_BAR;
        PG8_WAIT_V(4); PG8_BAR;
        PG8_STAGE(PG8_SB(1, 0), cB + kstep, voffB); PG8_STAGE(PG8_SA(1, 0), cA + kstep, voffA); PG8_STAGE(PG8_SB(1, 1), cB + hstepB + kstep, voffB);
        PG8_WAIT_V(6); PG8_BAR;
    }
    for (;;) {
        const bool has_next = S.next(ui + 1, nxt);
        const char* nA = has_next ? S.aptr(nxt) : cA; const char* nB = has_next ? S.bptr(nxt) : cB;
        for (int t = 0; t < nt; t += 2) {
            const bool last = (t == nt - 2);
            const char* a1 = cA + (size_t)(t + 1) * kstep;
            const char* a2 = last ? nA : cA + (size_t)(t + 2) * kstep; const char* b2 = last ? nB : cB + (size_t)(t + 2) * kstep;
            const char* a3 = a2 + kstep; const char* b3 = b2 + kstep;
            if constexpr (SP2) {
            PG8_LDB(B0, 0, 0); PG8_LDB(B1, 0, 1); PG8_SCHED; PG8_LDA(At, 0, 0); PG8_STAGE(PG8_SA(1, 1), a1 + hstepA, voffA);
            PG8_WAIT_V(8); PG8_WAIT_L(0); PG8_BAR; PG8_MMA(0, 0, At, B0); PG8_MMA(0, 1, At, B1); PG8_BAR; PG8_SCHED;
            PG8_LDA(At, 0, 1); PG8_STAGE(PG8_SB(0, 0), b2, voffB); PG8_STAGE(PG8_SB(0, 1), b2 + hstepB, voffB); PG8_STAGE(PG8_SA(0, 0), a2, voffA);
            PG8_WAIT_V(8); PG8_WAIT_L(0); PG8_BAR; PG8_MMA(1, 0, At, B0); PG8_MMA(1, 1, At, B1); PG8_BAR; PG8_SCHED;
            PG8_LDB(B0, 1, 0); PG8_LDB(B1, 1, 1); PG8_SCHED; PG8_LDA(At, 1, 0); PG8_STAGE(PG8_SA(0, 1), a2 + hstepA, voffA);
            PG8_WAIT_V(8); PG8_WAIT_L(0); PG8_BAR; PG8_MMA(0, 0, At, B0); PG8_MMA(0, 1, At, B1); PG8_BAR; PG8_SCHED;
            PG8_LDA(At, 1, 1); PG8_STAGE(PG8_SB(1, 0), b3, voffB); PG8_STAGE(PG8_SB(1, 1), b3 + hstepB, voffB); PG8_STAGE(PG8_SA(1, 0), a3, voffA);
            PG8_WAIT_V(8); PG8_WAIT_L(0); PG8_BAR; PG8_MMA(1, 0, At, B0); PG8_MMA(1, 1, At, B1); PG8_BAR; PG8_SCHED;
            } else {
            PG8_LDB(B0, 0, 0); PG8_SCHED; PG8_LDA(At, 0, 0); PG8_STAGE(PG8_SA(1, 1), a1 + hstepA, voffA);
            PG8_WAIT_L(8); PG8_BAR; PG8_WAIT_L(0); PG8_MMA(0, 0, At, B0); PG8_BAR; PG8_SCHED;
            PG8_LDB(B1, 0, 1); PG8_STAGE(PG8_SB(0, 0), b2, voffB);
            PG8_BAR; PG8_WAIT_L(0); PG8_MMA(0, 1, At, B1); PG8_BAR;
            PG8_LDA(At, 0, 1); PG8_STAGE(PG8_SA(0, 0), a2, voffA);
            PG8_BAR; PG8_WAIT_L(0); PG8_MMA(1, 0, At, B0); PG8_BAR; PG8_SCHED;
            PG8_STAGE(PG8_SB(0, 1), b2 + hstepB, voffB);
            PG8_WAIT_V(6); PG8_BAR; PG8_MMA(1, 1, At, B1); PG8_BAR;
            PG8_LDB(B0, 1, 0); PG8_SCHED; PG8_LDA(At, 1, 0); PG8_STAGE(PG8_SA(0, 1), a2 + hstepA, voffA);
            PG8_WAIT_L(8); PG8_BAR; PG8_WAIT_L(0); PG8_MMA(0, 0, At, B0); PG8_BAR; PG8_SCHED;
            PG8_LDB(B1, 1, 1); PG8_STAGE(PG8_SB(1, 0), b3, voffB);
            PG8_BAR; PG8_WAIT_L(0); PG8_MMA(0, 1, At, B1); PG8_BAR;
            PG8_LDA(At, 1, 1); PG8_STAGE(PG8_SA(1, 0), a3, voffA);
            PG8_BAR; PG8_WAIT_L(0); PG8_MMA(1, 0, At, B0); PG8_BAR; PG8_SCHED;
            PG8_STAGE(PG8_SB(1, 1), b3 + hstepB, voffB);
            PG8_WAIT_V(6); PG8_BAR; PG8_MMA(1, 1, At, B1); PG8_BAR;
            }
        }
        if constexpr (ALIGN_EPI) { if (wr == 0) PG8_BAR; }
        E(acc, cur, wr, wc, fr, fq);
        if (!has_next) break;
        if (E.zero_after(cur)) {
#pragma unroll
        for (int a = 0; a < 2; ++a)
#pragma unroll
            for (int b = 0; b < 2; ++b)
#pragma unroll
                for (int m = 0; m < 4; ++m)
#pragma unroll
                    for (int n = 0; n < 2; ++n) acc[a][b][m][n] = (f32x4){0.f, 0.f, 0.f, 0.f};
        }
        cur = nxt; cA = nA; cB = nB; ++ui;
        if constexpr (ALIGN_EPI) { if (wr == 1) PG8_BAR; }
    }
    PG8_WAIT_V(0);
    if constexpr (!ALIGN_EPI) { if (wr == 0) PG8_BAR; }
    PG8_BAR;
#undef PG8_SA
#undef PG8_SB
#undef PG8_STAGE
#undef PG8_LDA
#undef PG8_LDB
#undef PG8_MMA
#undef PG8_WAIT_V
#undef PG8_WAIT_L
#undef PG8_BAR
#undef PG8_SCHED
}

struct EpiProj {
    static constexpr bool PERM = true;
    bf16_t* O; size_t split_stride;
    __device__ __forceinline__ bool zero_after(const Unit&) const { return true; }
    __device__ __forceinline__ void operator()(f32x4 (&acc)[2][2][4][2], const Unit& u, int wr, int wc, int fr, int fq) const {
        const int row0 = u.pm * BM + wr * 64 + fr; const int t = u.pn >> 2; bf16_t* base = O + (size_t)t * split_stride;
        const int col0 = (u.pn & 3) * BM + wc * 32 + 8 * fq;
#pragma unroll
        for (int ai = 0; ai < 2; ++ai)
#pragma unroll
            for (int m = 0; m < 4; ++m) { bf16_t* rowp = base + (size_t)(row0 + ai * HALF + m * 16) * 1024 + col0;
#pragma unroll
                for (int bj = 0; bj < 2; ++bj) { const f32x4 v0 = acc[ai][bj][m][0], v1 = acc[ai][bj][m][1];
                    u32x4 w; w.x = cvt_pk_bf16(v0[0], v0[1]); w.y = cvt_pk_bf16(v0[2], v0[3]); w.z = cvt_pk_bf16(v1[0], v1[1]); w.w = cvt_pk_bf16(v1[2], v1[3]);
                    *(u32x4*)(rowp + bj * HALF) = w; } }
    }
};
struct EpiGate {
    static constexpr bool PERM = false;
    const bf16_t* XR; float* Aout; bf16_t* Bout; const float* b_a; const float* b_x; const float* a_param;
    __device__ __forceinline__ bool zero_after(const Unit&) const { return true; }
    __device__ __forceinline__ void operator()(f32x4 (&acc)[2][2][4][2], const Unit& u, int wr, int wc, int fr, int fq) const {
        int ch0 = u.pn * 128 + wc * 32 + 4 * fq; asm volatile("" : "+v"(ch0));
        f32x4 ba[2], bx[2], sp[2];
#pragma unroll
        for (int n = 0; n < 2; ++n) { ba[n] = *(const f32x4*)(b_a + ch0 + 16 * n); bx[n] = *(const f32x4*)(b_x + ch0 + 16 * n); sp[n] = *(const f32x4*)(a_param + ch0 + 16 * n); }
#pragma unroll
        for (int ai = 0; ai < 2; ++ai)
#pragma unroll
            for (int m = 0; m < 4; ++m) { const int row = u.pm * BM + ai * HALF + wr * 64 + m * 16 + fr; const bool first = (row & (SEQ - 1)) == 0;
#pragma unroll
                for (int n = 0; n < 2; ++n) { const size_t off = (size_t)row * 1024 + ch0 + 16 * n;
                    const u32x2 xw = *(const u32x2*)(XR + off); const float xv[4] = {bflo(xw.x), bfhi(xw.x), bflo(xw.y), bfhi(xw.y)};
                    f32x4 av; float bv[4];
#pragma unroll
                    for (int e = 0; e < 4; ++e) { const float r = sigmoidf_(acc[ai][0][m][n][e] + ba[n][e]), ig = sigmoidf_(acc[ai][1][m][n][e] + bx[n][e]);
                        const float la = sp[n][e] * r; const float a = fast_exp(la); const float mult = first ? 1.0f : sqrtf(fmaxf(1.0f - a * a, 0.f));
                        av[e] = a; bv[e] = xv[e] * ig * mult; }
                    *(f32x4*)(Aout + off) = av; u32x2 bw; bw.x = cvt_pk_bf16(bv[0], bv[1]); bw.y = cvt_pk_bf16(bv[2], bv[3]); *(u32x2*)(Bout + off) = bw; } }
    }
};
struct EpiMerge {
    static constexpr bool PERM = true;
    const bf16_t* GA; const bf16_t* GB; bf16_t* O;
    __device__ __forceinline__ bool zero_after(const Unit& u) const { return u.seg != 0; }
    __device__ __forceinline__ void operator()(f32x4 (&acc)[2][2][4][2], const Unit& u, int wr, int wc, int fr, int fq) const {
        const int row0 = u.pm * BM + wr * 64 + fr, col0 = u.pn * BM + wc * 32 + 8 * fq;
#pragma unroll
        for (int ai = 0; ai < 2; ++ai)
#pragma unroll
            for (int m = 0; m < 4; ++m)
#pragma unroll
                for (int bj = 0; bj < 2; ++bj) { const size_t off = (size_t)(row0 + ai * HALF + m * 16) * 1024 + col0 + bj * HALF;
                    const u32x4 gb = *(const u32x4*)(GB + off);
                    float gbv[8] = {bflo(gb.x), bfhi(gb.x), bflo(gb.y), bfhi(gb.y), bflo(gb.z), bfhi(gb.z), bflo(gb.w), bfhi(gb.w)};
                    if (u.seg == 0) {
                        const u32x4 ga = *(const u32x4*)(GA + off);
                        float gav[8] = {bflo(ga.x), bfhi(ga.x), bflo(ga.y), bfhi(ga.y), bflo(ga.z), bfhi(ga.z), bflo(ga.w), bfhi(ga.w)};
#pragma unroll
                        for (int j = 0; j < 8; ++j) { const float eb = fast_exp(-fminf(fmaxf(gbv[j], -30.f), 30.f)), ea = fast_exp(-fminf(fmaxf(gav[j], -30.f), 30.f));
                            acc[ai][bj][m][j >> 2][j & 3] *= (1.0f + eb) * __builtin_amdgcn_rcpf(1.0f + ea); }
                    } else {
                        float o[8];
#pragma unroll
                        for (int j = 0; j < 8; ++j) { const float eb = fast_exp(-fminf(fmaxf(gbv[j], -30.f), 30.f)); o[j] = acc[ai][bj][m][j >> 2][j & 3] * __builtin_amdgcn_rcpf(1.0f + eb); }
                        u32x4 w; w.x = cvt_pk_bf16(o[0], o[1]); w.y = cvt_pk_bf16(o[2], o[3]); w.z = cvt_pk_bf16(o[4], o[5]); w.w = cvt_pk_bf16(o[6], o[7]);
                        *(u32x4*)(O + off) = w; } }
    }
};
struct EpiRes {
    static constexpr bool PERM = false;
    const float* base; float* out; const float* gate;
    __device__ __forceinline__ bool zero_after(const Unit&) const { return true; }
    __device__ __forceinline__ void operator()(f32x4 (&acc)[2][2][4][2], const Unit& u, int wr, int wc, int fr, int fq) const {
        const int row0 = u.pm * BM + wr * 64 + fr, col0 = u.pn * BM + wc * 32 + 4 * fq; const int b = u.pm >> 4;
        f32x4 gv[2][2];
#pragma unroll
        for (int bj = 0; bj < 2; ++bj)
#pragma unroll
            for (int n = 0; n < 2; ++n) gv[bj][n] = *(const f32x4*)(gate + (size_t)b * NMOD + col0 + bj * HALF + n * 16);
#pragma unroll
        for (int ai = 0; ai < 2; ++ai)
#pragma unroll
            for (int m = 0; m < 4; ++m) { const size_t off = (size_t)(row0 + ai * HALF + m * 16) * 1024 + col0;
#pragma unroll
                for (int bj = 0; bj < 2; ++bj)
#pragma unroll
                    for (int n = 0; n < 2; ++n) { const f32x4 bs = *(const f32x4*)(base + off + bj * HALF + n * 16); *(f32x4*)(out + off + bj * HALF + n * 16) = bs + gv[bj][n] * acc[ai][bj][m][n]; } }
    }
};
struct EpiUp {
    static constexpr bool PERM = true;
    bf16_t* O;
    __device__ __forceinline__ bool zero_after(const Unit&) const { return true; }
    __device__ __forceinline__ void operator()(f32x4 (&acc)[2][2][4][2], const Unit& u, int wr, int wc, int fr, int fq) const {
        const int row0 = u.pm * BM + wr * 64 + fr, col0 = u.pn * BM + wc * 32 + 8 * fq;
#pragma unroll
        for (int ai = 0; ai < 2; ++ai)
#pragma unroll
            for (int m = 0; m < 4; ++m) { bf16_t* rowp = O + (size_t)(row0 + ai * HALF + m * 16) * FF + col0;
#pragma unroll
                for (int bj = 0; bj < 2; ++bj) { f32x4 v0 = acc[ai][bj][m][0], v1 = acc[ai][bj][m][1];
#pragma unroll
                    for (int e = 0; e < 4; ++e) { const float a = fmaxf(v0[e], 0.f), b = fmaxf(v1[e], 0.f); v0[e] = a * a; v1[e] = b * b; }
                    u32x4 w; w.x = cvt_pk_bf16(v0[0], v0[1]); w.y = cvt_pk_bf16(v0[2], v0[3]); w.z = cvt_pk_bf16(v1[0], v1[1]); w.w = cvt_pk_bf16(v1[2], v1[3]);
                    *(u32x4*)(rowp + bj * HALF) = w; } }
    }
};
}

struct Args { const float* in[23]; float* out; unsigned char* ws; };

__device__ __forceinline__ void transpose_item(const float* W, int ld, int k0, int n0, bf16_t* WT, int row_base, int ldo, LAS float* scr, int lane) {
#pragma unroll 8
    for (int i = 0; i < 32; ++i) { const int kk = 2 * i + (lane >> 5); scr[kk * 33 + (lane & 31)] = W[(size_t)(k0 + kk) * ld + n0 + (lane & 31)]; }
    LDS_WAIT(); asm volatile("" ::: "memory");
    const int c = lane & 7;
#pragma unroll
    for (int j = 0; j < 4; ++j) { const int n = (lane >> 3) + 8 * j; const LAS float* s = scr + (8 * c) * 33 + n;
        u32x4 o; o.x = pk2(s[0 * 33], s[1 * 33]); o.y = pk2(s[2 * 33], s[3 * 33]); o.z = pk2(s[4 * 33], s[5 * 33]); o.w = pk2(s[6 * 33], s[7 * 33]);
        *(u32x4*)(WT + (size_t)(row_base + n) * ldo + k0 + 8 * c) = o; }
    LDS_WAIT(); asm volatile("" ::: "memory");
}

__device__ __forceinline__ void norm_row_to_bf16(const float* xrow, bf16_t* orow, const LAS float* tab, int lane) {
    const f32x4* xr = (const f32x4*)xrow + lane;
    f32x4 v[4]; float s = 0.f;
#pragma unroll
    for (int j = 0; j < 4; ++j) { v[j] = xr[64 * j]; s += (v[j].x * v[j].x + v[j].y * v[j].y) + (v[j].z * v[j].z + v[j].w * v[j].w); }
    const float rstd = 1.0f / sqrtf(wave_sum(s) * (1.f / D) + EPS);
    unsigned long long* o8 = (unsigned long long*)orow + lane;
#pragma unroll
    for (int j = 0; j < 4; ++j) { const f32x4 sc = *(const LAS f32x4*)(tab + 4 * lane + 256 * j), sh = *(const LAS f32x4*)(tab + 1024 + 4 * lane + 256 * j);
        const f32x4 h = v[j] * rstd * sc + sh;
        o8[64 * j] = (unsigned long long)pk2(h.x, h.y) | ((unsigned long long)pk2(h.z, h.w) << 32); }
}

__global__ void __launch_bounds__(NWAVES * 64, 2) fwd_kernel(Args args) {
    extern __shared__ __attribute__((aligned(16))) unsigned char lds_raw[];
    LAS unsigned char* lds = (LAS unsigned char*)lds_raw;
    volatile LAS unsigned* MISC = (volatile LAS unsigned*)(lds + MISC_OFF);
    int tid, lane, wave, gw, gtid;
    const int G = gridDim.x, bx = blockIdx.x;
    const int vcu = (G % 8 == 0) ? (bx % 8) * (G / 8) + bx / 8 : bx;
    const int NGW = G * NWAVES, NGT = G * NWAVES * 64;
    wave = __builtin_amdgcn_readfirstlane((int)threadIdx.x >> 6);
#define REFRESH() do { tid = tid_from_wave(wave); lane = tid & 63; gw = vcu * NWAVES + wave; gtid = bx * (NWAVES * 64) + tid; } while (0)
    REFRESH();
    unsigned char* ws = args.ws;
    for (int u = tid; u < (LDS_BYTES - LDSCTL_OFF) / 4; u += NWAVES * 64) ((LAS unsigned*)(lds + LDSCTL_OFF))[u] = 0u;
    __syncthreads();
    gu32* ctl = (gu32*)(ws + WS_CTL);
    XcdBarrier bar = xcd_barrier_post((unsigned*)(ctl + CW_BAR), MISC + 8);

    const float* x = args.in[0]; const float* cvec = args.in[1]; const float* g_mix = args.in[2]; const float* g_mlp = args.in[3];
    const float* w_ada = args.in[4]; const float* b_ada = args.in[5]; const float* w_in = args.in[6]; const float* conv_w = args.in[7]; const float* conv_b = args.in[8];
    const float* w_rg_a = args.in[9]; const float* b_rg_a = args.in[10]; const float* w_rg_x = args.in[11]; const float* b_rg_x = args.in[12]; const float* a_param = args.in[13];
    const float* w_br_a = args.in[14]; const float* w_pool = args.in[15]; const float* b_pool = args.in[16]; const float* pool_scale = args.in[17]; const float* w_br_b = args.in[18];
    const float* w_out = args.in[19]; const float* w_up = args.in[20]; const float* w_down = args.in[21]; const float* final_g = args.in[22];
    float* out = args.out;
    float* MODP = (float*)(ws + WS_MODP); float* MODF = (float*)(ws + WS_MODF); float* SPT = (float*)(ws + WS_SPT);
    bf16_t* WIN = (bf16_t*)(ws + WS_WIN); bf16_t* WA = (bf16_t*)(ws + WS_WA); bf16_t* WB = (bf16_t*)(ws + WS_WB); bf16_t* WO = (bf16_t*)(ws + WS_WO);
    bf16_t* WUP = (bf16_t*)(ws + WS_WUP); bf16_t* WDN = (bf16_t*)(ws + WS_WDN); bf16_t* WG = (bf16_t*)(ws + WS_WG);
    bf16_t* HB = (bf16_t*)(ws + WS_H); bf16_t* XB = (bf16_t*)(ws + WS_X); bf16_t* YB = (bf16_t*)(ws + WS_Y); bf16_t* VB = (bf16_t*)(ws + WS_V);
    bf16_t* GAB = (bf16_t*)(ws + WS_GA); bf16_t* GBB = (bf16_t*)(ws + WS_GB); bf16_t* FFB = (bf16_t*)(ws + WS_FF);

    if (vcu < 192) {
        const int cg = vcu % 96, kh = vcu / 96, n = cg * 64 + lane, k0 = kh * 512 + wave * 64;
        float ca[4];
#pragma unroll
        for (int b = 0; b < 4; ++b) { const float c = cvec[b * D + k0 + lane]; ca[b] = c * sigmoidf_(c); }
        float acc4[4] = {0.f, 0.f, 0.f, 0.f};
#pragma unroll 16
        for (int r = 0; r < 64; ++r) { const float w = w_ada[(size_t)(k0 + r) * NMOD + n];
#pragma unroll
            for (int b = 0; b < 4; ++b) acc4[b] += __uint_as_float(__builtin_amdgcn_readlane(__float_as_uint(ca[b]), r)) * w; }
        LAS float* red = (LAS float*)lds;
#pragma unroll
        for (int b = 0; b < 4; ++b) red[(wave * 4 + b) * 64 + lane] = acc4[b];
        __syncthreads();
        if (tid < 256) { const int b = tid >> 6, l = tid & 63; float s = 0.f;
#pragma unroll
            for (int w = 0; w < 8; ++w) s += red[(w * 4 + b) * 64 + l];
            if (kh == 0) s += b_ada[cg * 64 + l];
            MODP[(size_t)(kh * 4 + b) * NMOD + cg * 64 + l] = s; }
        __syncthreads();
    }
    xcd_barrier(bar); REFRESH();

    {
        for (int tile = vcu; tile < 256; tile += G) {
            const int k0 = (tile >> 4) * 64, n0 = (tile & 15) * 64, g = n0 >> 8, np0 = n0 & 255;
            LAS float* As = (LAS float*)lds;
            LAS float* Bs = (LAS float*)(lds + 65792);
            for (int idx = tid; idx < 64 * 256; idx += 512) { const int kk = idx >> 8, i = idx & 255; As[kk * 257 + i] = w_in[(size_t)(k0 + kk) * DIN + 2048 + 256 * g + i]; }
            for (int idx = tid; idx < 256 * 64; idx += 512) { const int i = idx >> 6, nn = idx & 63; Bs[i * 64 + nn] = w_pool[(size_t)g * 65536 + (size_t)i * 256 + np0 + nn]; }
            __syncthreads();
            const int kk = tid & 63, ng = tid >> 6;
            float a8[8] = {0.f, 0.f, 0.f, 0.f, 0.f, 0.f, 0.f, 0.f};
#pragma unroll 4
            for (int i = 0; i < 256; ++i) { const float a = As[kk * 257 + i]; const f32x4 b0 = *(const LAS f32x4*)(Bs + i * 64 + 8 * ng), b1 = *(const LAS f32x4*)(Bs + i * 64 + 8 * ng + 4);
                a8[0] += a * b0.x; a8[1] += a * b0.y; a8[2] += a * b0.z; a8[3] += a * b0.w; a8[4] += a * b1.x; a8[5] += a * b1.y; a8[6] += a * b1.z; a8[7] += a * b1.w; }
#pragma unroll
            for (int j = 0; j < 8; ++j) WIN[(size_t)(2048 + n0 + 8 * ng + j) * 1024 + k0 + kk] = (bf16_t)f2bf(a8[j]);
            __syncthreads();
        }
        {
            LAS float* scr = (LAS float*)(lds + wave * 16384);
            constexpr int I_IN = 16 * 64, I_SQ = 16 * 32, I_UP = 16 * 128, I_DN = 64 * 32, I_G = 4 * 4 * 8;
            constexpr int NITEMS = 2 * I_IN + 3 * I_SQ + I_UP + I_DN + 2 * I_G;
            for (int it = gw; it < NITEMS; it += NGW) {
                int r = it;
                if (r < I_IN) { const int kb = r / 64, nb = r % 64; transpose_item(w_in, DIN, 64 * kb, 32 * nb, WIN, 32 * nb, 1024, scr, lane); continue; } r -= I_IN;
                if (r < I_IN) { const int kb = r / 64, nb = r % 64; transpose_item(w_in, DIN, 64 * kb, 3072 + 32 * nb, WIN, 3072 + 32 * nb, 1024, scr, lane); continue; } r -= I_IN;
                if (r < I_SQ) { const int kb = r / 32, nb = r % 32; transpose_item(w_br_a, D, 64 * kb, 32 * nb, WA, 32 * nb, 1024, scr, lane); continue; } r -= I_SQ;
                if (r < I_SQ) { const int kb = r / 32, nb = r % 32; transpose_item(w_br_b, D, 64 * kb, 32 * nb, WB, 32 * nb, 1024, scr, lane); continue; } r -= I_SQ;
                if (r < I_SQ) { const int kb = r / 32, nb = r % 32; transpose_item(w_out, D, 64 * kb, 32 * nb, WO, 32 * nb, 1024, scr, lane); continue; } r -= I_SQ;
                if (r < I_UP) { const int kb = r / 128, nb = r % 128; transpose_item(w_up, FF, 64 * kb, 32 * nb, WUP, 32 * nb, 1024, scr, lane); continue; } r -= I_UP;
                if (r < I_DN) { const int kb = r / 32, nb = r % 32; transpose_item(w_down, D, 64 * kb, 32 * nb, WDN, 32 * nb, 4096, scr, lane); continue; } r -= I_DN;
                { const int gate = r / I_G; r -= gate * I_G; const int g = r / 32, q = r % 32, kb = q / 8, nb = q % 8, j0 = 32 * nb;
                  const int row_base = (g * 2 + (j0 >> 7)) * 256 + gate * 128 + (j0 & 127);
                  transpose_item((gate ? w_rg_x : w_rg_a) + (size_t)g * 65536, 256, 64 * kb, j0, WG, row_base, 256, scr, lane); }
            }
        }
        __syncthreads();
        {
            LAS float* tab = (LAS float*)lds;
            for (int idx = tid; idx < 4 * 1024; idx += 512) { const int b = idx >> 10, c = idx & 1023;
                const float sh = MODP[(size_t)b * NMOD + c] + MODP[(size_t)(4 + b) * NMOD + c], sc = MODP[(size_t)b * NMOD + 1024 + c] + MODP[(size_t)(4 + b) * NMOD + 1024 + c];
                tab[b * 2048 + c] = g_mix[c] * (1.0f + sc); tab[b * 2048 + 1024 + c] = sh; }
            for (int idx = gtid; idx < 4 * NMOD; idx += NGT) MODF[idx] = MODP[idx] + MODP[4 * NMOD + idx];
            if (gtid < 1024) { const float p = a_param[gtid]; SPT[gtid] = -8.0f * (p > 20.f ? p : log1pf(expf(p))); }
            __syncthreads();
            for (int m = gw; m < M; m += NGW) norm_row_to_bf16(x + (size_t)m * D, HB + (size_t)m * D, tab + (m >> 12) * 2048, lane);
            __syncthreads();
        }
    }
    xcd_barrier(bar); REFRESH();

    {
        pg8::Sched S{}; S.nM = M / 256; S.nN = DIN / 256; S.G = G; S.c = bx; S.nseg = 1; S.A[0] = S.A[1] = (const char*)HB; S.B[0] = S.B[1] = (const char*)WIN; S.lda = 1024; S.ldb = 1024; S.acol_mul = 0; S.acol_shift = 0;
        pg8::EpiProj E{XB, (size_t)(WS_Y - WS_X) / 2};
        pg8::gemm_phase<pg8::EpiProj, true, true>(lds, S, 1024, E, wave);
    }
    xcd_barrier(bar); REFRESH();

    for (int idx = gtid; idx < M * 128; idx += NGT) {
        const int m = idx >> 7, c0 = (idx & 127) * 8, t = m & (SEQ - 1);
        float a8[8];
        { const f32x4 b0 = *(const f32x4*)(conv_b + c0), b1 = *(const f32x4*)(conv_b + c0 + 4); a8[0] = b0.x; a8[1] = b0.y; a8[2] = b0.z; a8[3] = b0.w; a8[4] = b1.x; a8[5] = b1.y; a8[6] = b1.z; a8[7] = b1.w; }
#pragma unroll
        for (int j = 0; j < 4; ++j) { if (t - 3 + j >= 0) {
            const u32x4 xv = *(const u32x4*)(XB + (size_t)(m - 3 + j) * 1024 + c0); const f32x4 w0 = *(const f32x4*)(conv_w + j * 1024 + c0), w1 = *(const f32x4*)(conv_w + j * 1024 + c0 + 4);
            a8[0] += bflo(xv.x) * w0.x; a8[1] += bfhi(xv.x) * w0.y; a8[2] += bflo(xv.y) * w0.z; a8[3] += bfhi(xv.y) * w0.w;
            a8[4] += bflo(xv.z) * w1.x; a8[5] += bfhi(xv.z) * w1.y; a8[6] += bflo(xv.w) * w1.z; a8[7] += bfhi(xv.w) * w1.w; } }
        u32x4 o; o.x = pk2(a8[0], a8[1]); o.y = pk2(a8[2], a8[3]); o.z = pk2(a8[4], a8[5]); o.w = pk2(a8[6], a8[7]);
        *(u32x4*)(HB + (size_t)m * 1024 + c0) = o;
    }
    xcd_barrier(bar); REFRESH();

    {
        pg8::Sched S{}; S.nM = M / 256; S.nN = 8; S.G = G; S.c = bx; S.nseg = 1; S.A[0] = S.A[1] = (const char*)HB; S.B[0] = S.B[1] = (const char*)WG; S.lda = 1024; S.ldb = 256; S.acol_mul = 256; S.acol_shift = 1;
        pg8::EpiGate E{HB, out, XB, b_rg_a, b_rg_x, SPT};
        pg8::gemm_phase<pg8::EpiGate, true, true>(lds, S, 256, E, wave);
    }
    xcd_barrier(bar); REFRESH();

    if (bx < 8) {
        const int idx = bx * 512 + tid, b = idx >> 10, ch = idx & 1023;
        const size_t base = (size_t)b * SEQ * 1024 + ch;
        float h = 0.f;
        for (int t0 = 0; t0 < SEQ; t0 += 8) {
            float av[8], bv[8], yv[8];
#pragma unroll
            for (int j = 0; j < 8; ++j) { const size_t o = base + (size_t)(t0 + j) * 1024; av[j] = out[o]; bv[j] = bf1(XB[o]); yv[j] = bf1(YB[o]); }
#pragma unroll
            for (int j = 0; j < 8; ++j) { h = (t0 + j == 0) ? bv[j] : av[j] * h + bv[j]; YB[base + (size_t)(t0 + j) * 1024] = (bf16_t)f2bf(gelu_tanh(yv[j]) * h); }
        }
    } else {
        const int nthr = (G - 8) * 512;
        for (int idx = (bx - 8) * 512 + tid; idx < M * 128; idx += nthr) {
            const int m = idx >> 7, c0 = (idx & 127) * 8, t = m & (SEQ - 1), gi = c0 >> 8, win = 2 << gi, cnt = (t + 1 < win) ? t + 1 : win;
            float s8[8] = {0.f, 0.f, 0.f, 0.f, 0.f, 0.f, 0.f, 0.f}; u32x4 cur = (u32x4){0u, 0u, 0u, 0u};
            for (int j = 0; j < cnt; ++j) { const u32x4 v = *(const u32x4*)(VB + (size_t)(m - j) * 1024 + c0); if (j == 0) cur = v;
                s8[0] += bflo(v.x); s8[1] += bfhi(v.x); s8[2] += bflo(v.y); s8[3] += bfhi(v.y); s8[4] += bflo(v.z); s8[5] += bfhi(v.z); s8[6] += bflo(v.w); s8[7] += bfhi(v.w); }
            const float inv = 1.0f / (float)cnt;
            const float c8[8] = {bflo(cur.x), bfhi(cur.x), bflo(cur.y), bfhi(cur.y), bflo(cur.z), bfhi(cur.z), bflo(cur.w), bfhi(cur.w)};
            const f32x4 bp0 = *(const f32x4*)(b_pool + c0), bp1 = *(const f32x4*)(b_pool + c0 + 4), ps0 = *(const f32x4*)(pool_scale + c0), ps1 = *(const f32x4*)(pool_scale + c0 + 4);
            const float bp[8] = {bp0.x, bp0.y, bp0.z, bp0.w, bp1.x, bp1.y, bp1.z, bp1.w}, ps[8] = {ps0.x, ps0.y, ps0.z, ps0.w, ps1.x, ps1.y, ps1.z, ps1.w};
            float o8[8];
#pragma unroll
            for (int e = 0; e < 8; ++e) o8[e] = (s8[e] * inv - c8[e] + bp[e]) * ps[e];
            u32x4 o; o.x = pk2(o8[0], o8[1]); o.y = pk2(o8[2], o8[3]); o.z = pk2(o8[4], o8[5]); o.w = pk2(o8[6], o8[7]);
            *(u32x4*)(HB + (size_t)m * 1024 + c0) = o;
        }
    }
    xcd_barrier(bar); REFRESH();

    {
        pg8::Sched S{}; S.nM = M / 256; S.nN = 4; S.G = G; S.c = bx; S.nseg = 2; S.A[0] = (const char*)YB; S.A[1] = (const char*)HB; S.B[0] = (const char*)WA; S.B[1] = (const char*)WB; S.lda = 1024; S.ldb = 1024; S.acol_mul = 0; S.acol_shift = 0;
        pg8::EpiMerge E{GAB, GBB, VB};
        pg8::gemm_phase<pg8::EpiMerge, true, true>(lds, S, 1024, E, wave);
    }
    xcd_barrier(bar); REFRESH();

    {
        pg8::Sched S{}; S.nM = M / 256; S.nN = 4; S.G = G; S.c = bx; S.nseg = 1; S.A[0] = S.A[1] = (const char*)VB; S.B[0] = S.B[1] = (const char*)WO; S.lda = 1024; S.ldb = 1024; S.acol_mul = 0; S.acol_shift = 0;
        pg8::EpiRes E{x, out, MODF + 2048};
        pg8::gemm_phase<pg8::EpiRes, true, true>(lds, S, 1024, E, wave);
    }
    xcd_barrier(bar); REFRESH();

    {
        LAS float* tab = (LAS float*)lds;
        for (int idx = tid; idx < 4 * 1024; idx += 512) { const int b = idx >> 10, c = idx & 1023;
            tab[b * 2048 + c] = g_mlp[c] * (1.0f + MODF[(size_t)b * NMOD + 4096 + c]); tab[b * 2048 + 1024 + c] = MODF[(size_t)b * NMOD + 3072 + c]; }
        __syncthreads();
        for (int m = gw; m < M; m += NGW) norm_row_to_bf16(out + (size_t)m * D, HB + (size_t)m * D, tab + (m >> 12) * 2048, lane);
        __syncthreads();
    }
    xcd_barrier(bar); REFRESH();

    {
        pg8::Sched S{}; S.nM = M / 256; S.nN = FF / 256; S.G = G; S.c = bx; S.nseg = 1; S.A[0] = S.A[1] = (const char*)HB; S.B[0] = S.B[1] = (const char*)WUP; S.lda = 1024; S.ldb = 1024; S.acol_mul = 0; S.acol_shift = 0;
        pg8::EpiUp E{FFB};
        pg8::gemm_phase<pg8::EpiUp, true, true>(lds, S, 1024, E, wave);
    }
    xcd_barrier(bar); REFRESH();

    {
        pg8::Sched S{}; S.nM = M / 256; S.nN = 4; S.G = G; S.c = bx; S.nseg = 1; S.A[0] = S.A[1] = (const char*)FFB; S.B[0] = S.B[1] = (const char*)WDN; S.lda = 4096; S.ldb = 4096; S.acol_mul = 0; S.acol_shift = 0;
        pg8::EpiRes E{out, out, MODF + 5120};
        pg8::gemm_phase<pg8::EpiRes, true, true>(lds, S, 4096, E, wave);
    }
    xcd_barrier(bar); REFRESH();

    for (int m = gw; m < M; m += NGW) {
        f32x4* xr = (f32x4*)(out + (size_t)m * D) + lane;
        f32x4 v[4]; float s = 0.f;
#pragma unroll
        for (int j = 0; j < 4; ++j) { v[j] = xr[64 * j]; s += (v[j].x * v[j].x + v[j].y * v[j].y) + (v[j].z * v[j].z + v[j].w * v[j].w); }
        const float rstd = 1.0f / sqrtf(wave_sum(s) * (1.f / D) + EPS);
#pragma unroll
        for (int j = 0; j < 4; ++j) { const f32x4 g = *((const f32x4*)final_g + lane + 64 * j); xr[64 * j] = v[j] * rstd * g; }
    }
}

extern "C" void kernel_launch(void* const* d_in, const int* in_sizes, int n_in, void* d_out, int out_size, void* d_ws, size_t ws_size, hipStream_t stream) {
    static int grid = 0;
    if (grid == 0) {
        if (n_in != 23 || in_sizes[0] != M * D || out_size != M * D || ws_size < WS_END) { fprintf(stderr, "kernel_launch: unexpected shapes (n_in %d, in0 %d, out %d, ws %zu); nothing launched\n", n_in, n_in > 0 ? in_sizes[0] : -1, out_size, ws_size); grid = -1; return; }
        int dev = 0, cus = 0, per_cu = 0;
        if (hipGetDevice(&dev) != hipSuccess || hipDeviceGetAttribute(&cus, hipDeviceAttributeMultiprocessorCount, dev) != hipSuccess) { fprintf(stderr, "kernel_launch: device query failed\n"); grid = -1; return; }
        if (hipFuncSetAttribute((const void*)fwd_kernel, hipFuncAttributeMaxDynamicSharedMemorySize, LDS_BYTES) != hipSuccess) { fprintf(stderr, "kernel_launch: hipFuncSetAttribute failed\n"); grid = -1; return; }
        if (hipOccupancyMaxActiveBlocksPerMultiprocessor(&per_cu, (const void*)fwd_kernel, NWAVES * 64, LDS_BYTES) != hipSuccess || per_cu < 1) { fprintf(stderr, "kernel_launch: occupancy query says %d blocks per CU\n", per_cu); (void)hipGetLastError(); grid = -1; return; }
        grid = cus;
    }
    if (grid < 0) return;
    (void)hipMemsetAsync((char*)d_ws + WS_CTL, 0, CTL_ZERO_BYTES, stream);
    Args a{};
    for (int i = 0; i < 23; ++i) a.in[i] = (const float*)d_in[i];
    a.out = (float*)d_out; a.ws = (unsigned char*)d_ws;
    void* kargs[] = {&a};
    hipError_t e = hipLaunchCooperativeKernel((const void*)fwd_kernel, dim3(grid), dim3(NWAVES * 64), kargs, LDS_BYTES, stream);
    if (e != hipSuccess) fprintf(stderr, "kernel_launch: cooperative launch failed: %s (grid %d)\n", hipGetErrorString(e), grid);
}
```

```cpp
#include <hip/hip_runtime.h>
#include <cstdio>
#include <cstdint>

#define GAS __attribute__((address_space(1)))
#define LAS __attribute__((address_space(3)))
typedef unsigned short bf16_t;
typedef short bf16x8 __attribute__((ext_vector_type(8)));
typedef float f32x4 __attribute__((ext_vector_type(4)));
typedef float f32x2 __attribute__((ext_vector_type(2)));
typedef float f32x16 __attribute__((ext_vector_type(16)));
typedef unsigned u32x4 __attribute__((ext_vector_type(4)));
typedef unsigned u32x2 __attribute__((ext_vector_type(2)));
typedef GAS unsigned gu32;

#ifndef REP_ALL
#define REP_ALL 1
#endif
#ifndef REP_BAR
#define REP_BAR 1
#endif
#ifndef REP_P1
#define REP_P1 1
#endif
#ifndef REP_P2
#define REP_P2 1
#endif
#ifndef REP_P6
#define REP_P6 1
#endif
#ifndef REP_P7
#define REP_P7 1
#endif
#ifndef REP_P9
#define REP_P9 1
#endif
#ifndef REP_P3
#define REP_P3 1
#endif
#ifndef REP_P10
#define REP_P10 1
#endif
#ifndef PREFETCH_EPI
#define PREFETCH_EPI 0
#endif
#ifndef STAGGER_TICKS
#define STAGGER_TICKS 0
#endif
#ifndef REP_P1A
#define REP_P1A 1
#endif
#ifndef REP_P1B
#define REP_P1B 1
#endif
#ifndef REP_P1C
#define REP_P1C 1
#endif
constexpr int NWAVES = 8;
constexpr int BATCH = 4, SEQ = 4096, D = 1024, DIN = 5120, FF = 4096, NMOD = 6144;
constexpr int M = BATCH * SEQ;
constexpr float EPS = 1e-6f;

constexpr size_t MiB = 1u << 20;
constexpr size_t WS_CTL = 0, CTL_ZERO_BYTES = 384 * 1024;
constexpr size_t WS_MODP = 1 * MiB;
constexpr size_t WS_MODF = 1 * MiB + 256 * 1024;
constexpr size_t WS_SPT = 1 * MiB + 512 * 1024;
constexpr size_t WS_WIN = 2 * MiB;
constexpr size_t WS_WA = 12 * MiB, WS_WB = 14 * MiB, WS_WO = 16 * MiB;
constexpr size_t WS_WUP = 18 * MiB;
constexpr size_t WS_WDN = 26 * MiB;
constexpr size_t WS_WG = 34 * MiB;
constexpr size_t WS_H = 36 * MiB;
constexpr size_t WS_X = 68 * MiB, WS_Y = 100 * MiB, WS_V = 132 * MiB, WS_GA = 164 * MiB, WS_GB = 196 * MiB;
constexpr size_t WS_FF = 68 * MiB;
constexpr size_t WS_XHALO = 228 * MiB;
constexpr size_t WS_END = 229 * MiB;
constexpr size_t WS_SUM = 35 * MiB;
constexpr size_t WS_XCH = 35 * MiB + 512 * 1024;
constexpr int N_WIN_ITEMS = 2 * 16 * 64, N_ALL_ITEMS = 2 * 16 * 64 + 3 * 16 * 32 + 16 * 128 + 64 * 32 + 2 * 4 * 4 * 8;
constexpr int CW_TMO = 0, CW_BAR = 4096, CW_RNN = 16384, CW_PAN = 65536;
constexpr int CW_TEAM = 81920, CW_XCC = 90112, CW_MOD = 90624, CW_WRDY = 90688;
static_assert((CW_WRDY + 64) * 4 <= (int)CTL_ZERO_BYTES && (CW_PAN + 2 * 64 * 64) <= CW_TEAM && (CW_RNN + 512 * 64) <= CW_PAN && (CW_TEAM + 64 * 64) <= CW_XCC, "control words inside the zeroed region");

constexpr unsigned PANEL_ELEMS = 5u * 256u * 1024u, PBUF_ELEMS = 256u * 1024u;
__host__ __device__ __forceinline__ unsigned prow(int r) { return (unsigned)(r >> 8) * PANEL_ELEMS + (unsigned)(r & 255) * 1024u; }
__host__ __device__ __forceinline__ unsigned pool_row(int r) { return (unsigned)(r >> 8) * 524288u + (unsigned)(r & 255) * 1024u; }
constexpr int RING_BYTES = 131072;
constexpr int LDSCTL_OFF = 143360, MISC_OFF = LDSCTL_OFF + 320;
constexpr int LDS_BYTES = 147456;
constexpr int JUNK_OFF = 145408;

#define LDS_WAIT() asm volatile("s_waitcnt lgkmcnt(0)" ::: "memory")
#define VM_WAIT() asm volatile("s_waitcnt vmcnt(0)" ::: "memory")
__device__ __forceinline__ unsigned f2bf(float f) { unsigned u = __builtin_bit_cast(unsigned, f); return (u + 0x7fffu + ((u >> 16) & 1u)) >> 16; }
__device__ __forceinline__ unsigned pk2(float lo, float hi) { return f2bf(lo) | (f2bf(hi) << 16); }
__device__ __forceinline__ float bflo(unsigned u) { return __uint_as_float(u << 16); }
__device__ __forceinline__ float bfhi(unsigned u) { return __uint_as_float(u & 0xffff0000u); }
__device__ __forceinline__ float bf1(bf16_t h) { return __uint_as_float((unsigned)h << 16); }
__device__ __forceinline__ unsigned cvt_pk_bf16(float lo, float hi) { unsigned r; asm volatile("v_cvt_pk_bf16_f32 %0, %1, %2" : "=v"(r) : "v"(lo), "v"(hi)); return r; }
__device__ __forceinline__ float vmax1(float a, float b) { float r; asm("v_max_f32 %0, %1, %2" : "=v"(r) : "v"(a), "v"(b)); return r; }
__device__ __forceinline__ f32x4 pk_sub4(f32x4 a, f32x4 b) {
    typedef float f32x2_ __attribute__((ext_vector_type(2)));
    f32x2_ al = {a[0], a[1]}, ah = {a[2], a[3]}, bl = {b[0], b[1]}, bh = {b[2], b[3]}, rl, rh;
    asm("v_pk_add_f32 %0, %1, %2 neg_lo:[0,1] neg_hi:[0,1]" : "=v"(rl) : "v"(al), "v"(bl));
    asm("v_pk_add_f32 %0, %1, %2 neg_lo:[0,1] neg_hi:[0,1]" : "=v"(rh) : "v"(ah), "v"(bh));
    return (f32x4){rl[0], rl[1], rh[0], rh[1]}; }
__device__ __forceinline__ float fast_exp(float x) { return __builtin_amdgcn_exp2f(x * 1.44269504089f); }
__device__ __forceinline__ float sigmoidf_(float x) { return __builtin_amdgcn_rcpf(1.0f + fast_exp(-x)); }
__device__ __forceinline__ float gelu_tanh(float y) { const float u = y * (1.0f + 0.044715f * y * y); return y * __builtin_amdgcn_rcpf(1.0f + fast_exp(-1.5957691216f * u)); }
__device__ __forceinline__ float sum_rows4(float q) {
    { const unsigned u = __float_as_uint(q); const auto r = __builtin_amdgcn_permlane16_swap(u, u, false, false); q = __uint_as_float(r[0]) + __uint_as_float(r[1]); }
    { const unsigned u = __float_as_uint(q); const auto r = __builtin_amdgcn_permlane32_swap(u, u, false, false); q = __uint_as_float(r[0]) + __uint_as_float(r[1]); }
    return q; }
__device__ __forceinline__ float wave_sum(float v) {
#pragma unroll
    for (int o = 1; o < 64; o <<= 1) v += __shfl_xor(v, o);
    return v;
}

__device__ __forceinline__ int tid_from_wave(int wave_s) { int l; asm volatile("v_mbcnt_lo_u32_b32 %0, -1, 0\n\tv_mbcnt_hi_u32_b32 %0, -1, %0" : "=v"(l)); return wave_s * 64 + l; }
#define XB_TMO      128
#define XB_XCNT(j)  (256  + 64 * (j))
#define XB_XSUB(j)  (1280 + 64 * (j))
#define XB_XGEN(j)  (2304 + 64 * (j))
#define XB_TOP      3328
#define XB_TOPGEN   3392
#define XCD_BAR_WORDS 3456
#define XB_SPIN_CAP (1u << 18)
__device__ __forceinline__ unsigned xb_ld(unsigned* p)              { return __hip_atomic_load(p, __ATOMIC_RELAXED, __HIP_MEMORY_SCOPE_AGENT); }
__device__ __forceinline__ unsigned xb_add(unsigned* p, unsigned v) { return __hip_atomic_fetch_add(p, v, __ATOMIC_RELAXED, __HIP_MEMORY_SCOPE_AGENT); }
__device__ __forceinline__ unsigned xb_xcc_id() { return (unsigned)__builtin_amdgcn_s_getreg((3 << 11) | 20) & 0xFu; }
#define XB_SPIN(cond, bar) do { unsigned _sp = 0; while (cond) { __builtin_amdgcn_s_sleep(1); \
    if ((++_sp & 255u) == 0u) { if (xb_ld(&(bar)[XB_TMO])) break; if (_sp > XB_SPIN_CAP) { atomicAdd(&(bar)[XB_TMO], 1u); break; } } } } while (0)
#define GB_MOD    (XCD_BAR_WORDS)
#define GB_DEPART (XCD_BAR_WORDS + 64)
#define GB_READY  (XCD_BAR_WORDS + 32)
__device__ unsigned g_sync[XCD_BAR_WORDS + 128];
struct XcdBarrier { unsigned* bar; unsigned x; volatile LAS unsigned* st; };
__device__ __forceinline__ XcdBarrier xcd_barrier_post(unsigned* bar, volatile LAS unsigned* st) {
    XcdBarrier b; b.bar = bar; b.x = xb_xcc_id(); b.st = st;
    if (threadIdx.x == 0) (void)xb_add(&bar[XB_XCNT(b.x)], 1u);
    return b;
}
__device__ __forceinline__ void xcd_barrier_complete(unsigned* bar, unsigned x, unsigned& nloc, unsigned& nx) {
    const unsigned G = gridDim.x * gridDim.y * gridDim.z;
    unsigned sum, cnt, mine, sp = 0u;
    for (;;) {
        sum = 0u; cnt = 0u; mine = 0u;
#pragma unroll
        for (unsigned j = 0; j < 16; ++j) { const unsigned c = xb_ld(&bar[XB_XCNT(j)]); sum += c; cnt += (c > 0u) ? 1u : 0u; mine = (j == x) ? c : mine; }
        if (sum == G) break;
        __builtin_amdgcn_s_sleep(1);
        if ((++sp & 255u) == 0u) { if (xb_ld(&bar[XB_TMO])) break; if (sp > XB_SPIN_CAP) { atomicAdd(&bar[XB_TMO], 1u); break; } }
    }
    nloc = mine > 0u ? mine : 1u; nx = cnt > 0u ? cnt : 1u;
}
__device__ __forceinline__ void xcd_barrier(const XcdBarrier& b) {
    asm volatile("s_waitcnt vmcnt(0)" ::: "memory");
    __syncthreads();
    if (threadIdx.x == 0) {
        unsigned* bar = b.bar;
        __builtin_amdgcn_s_waitcnt(0);
        unsigned nloc = b.st[0], nx = b.st[1];
        if (nloc == 0u) { xcd_barrier_complete(bar, b.x, nloc, nx); b.st[0] = nloc; b.st[1] = nx; }
        const unsigned old = xb_add(&bar[XB_XSUB(b.x)], 1u);
        const unsigned gen = old / nloc;
        if (old + 1u == (gen + 1u) * nloc) {
            __builtin_amdgcn_fence(__ATOMIC_RELEASE, "agent");
            asm volatile("s_waitcnt vmcnt(0)" ::: "memory");
            const unsigned og = xb_add(&bar[XB_TOP], 1u);
            const unsigned tg = og / nx;
            if (og + 1u == (tg + 1u) * nx) xb_add(&bar[XB_TOPGEN], 1u);
            else XB_SPIN(xb_ld(&bar[XB_TOPGEN]) == tg, bar);
            __builtin_amdgcn_fence(__ATOMIC_ACQUIRE, "agent");
            xb_add(&bar[XB_XGEN(b.x)], 1u);
            asm volatile("s_waitcnt vmcnt(0)" ::: "memory");
        } else {
            XB_SPIN(xb_ld(&bar[XB_XGEN(b.x)]) == gen, bar);
            __builtin_amdgcn_fence(__ATOMIC_ACQUIRE, "agent");
            asm volatile("s_waitcnt vmcnt(0)" ::: "memory");
        }
    }
    __syncthreads();
}

template <int LPR> __device__ __forceinline__ void prefetch_tile(const char* base, size_t pitch, LAS unsigned char* lds, int tid) {
#pragma unroll
    for (int j = 0; j < 256 * LPR / 512; ++j) { const int q = tid + 512 * j, row = q / LPR, ln = q % LPR;
        __builtin_amdgcn_global_load_lds((const unsigned*)(base + (size_t)row * pitch + ln * 128), (LAS unsigned*)(lds + JUNK_OFF), 4, 0, 0); }
}
struct TeamBar { unsigned* cnt; volatile LAS unsigned* same; unsigned* tmo; };
__device__ __forceinline__ void team_barrier(const TeamBar& t, unsigned target, bool force_release = false, unsigned* ncnt = nullptr, unsigned ntarget = 0u) {
    asm volatile("s_waitcnt vmcnt(0)" ::: "memory");
    __syncthreads();
    if (threadIdx.x == 0) {
        if (t.same[0] == 0u || force_release) { __builtin_amdgcn_fence(__ATOMIC_RELEASE, "agent"); asm volatile("s_waitcnt vmcnt(0)" ::: "memory"); }
        xb_add(t.cnt, 1u);
        const bool early = t.same[0] != 0u && !force_release && ncnt == nullptr;
        if (early) asm volatile("buffer_inv sc1" ::: "memory");
        unsigned sp = 0u;
        while (xb_ld(t.cnt) < target) { __builtin_amdgcn_s_sleep(1); if (++sp > (1u << 22)) { atomicAdd(t.tmo, 1u); break; } }
        if (ncnt) { sp = 0u; while (xb_ld(ncnt) < ntarget) { __builtin_amdgcn_s_sleep(1); if (++sp > (1u << 22)) { atomicAdd(t.tmo, 1u); break; } } }
        if (!early) __builtin_amdgcn_fence(__ATOMIC_ACQUIRE, "agent");
        asm volatile("s_waitcnt vmcnt(0)" ::: "memory");
    }
    __syncthreads();
}
__device__ __forceinline__ void team_arrive(const TeamBar& t) {
    asm volatile("s_waitcnt vmcnt(0)" ::: "memory");
    __syncthreads();
    if (threadIdx.x == 0) { if (t.same[0] == 0u) { __builtin_amdgcn_fence(__ATOMIC_RELEASE, "agent"); asm volatile("s_waitcnt vmcnt(0)" ::: "memory"); } xb_add(t.cnt, 1u); }
}
__device__ __forceinline__ void team_wait(const TeamBar& t, unsigned target) {
    if (threadIdx.x == 0) { unsigned sp = 0u;
        while (xb_ld(t.cnt) < target) { __builtin_amdgcn_s_sleep(1); if (++sp > (1u << 22)) { atomicAdd(t.tmo, 1u); break; } }
        __builtin_amdgcn_fence(__ATOMIC_ACQUIRE, "agent"); asm volatile("s_waitcnt vmcnt(0)" ::: "memory"); }
    __syncthreads();
}
namespace pg8 {
constexpr int BM = 256, BK = 64, HALF = 128, HTB = HALF * BK * 2, NXCD = 8, WGM = 8;
__host__ __device__ __forceinline__ int lds_byte(int r, int c) { const int st = (r >> 4) * 2 + (c >> 5), rr = r & 15, cc = c & 31, ob = rr * 64 + cc * 2; return st * 1024 + (ob ^ (((ob >> 9) & 1) << 5)); }
__host__ __device__ __forceinline__ void stage_rc(int b, int& R, int& C) { const int st = b / 1024, sb = b % 1024, swz = sb ^ (((sb >> 9) & 1) << 5); R = (st >> 1) * 16 + swz / 64; C = (st & 1) * 32 + (swz % 64) / 2; }
__host__ __device__ __forceinline__ int perm32(int rho) { const int n = rho >> 4, i = rho & 15; return 8 * (i >> 2) + 4 * n + (i & 3); }

struct Unit { int pm, pn, seg; };
__device__ __forceinline__ bool tile_of(int L, int nM, int nN, Unit& u) {
    const int nwg = nM * nN; if (L >= nwg) return false;
    int wgid = L; { const int q = nwg / NXCD, r = nwg % NXCD, xcd = wgid % NXCD, off = wgid / NXCD; wgid = (xcd < r ? xcd * (q + 1) : r * (q + 1) + (xcd - r) * q) + off; }
    const int nig = WGM * nN, gid = wgid / nig, fm = gid * WGM, gsz = (nM - fm) < WGM ? (nM - fm) : WGM;
    u.pm = fm + ((wgid % nig) % gsz); u.pn = (wgid % nig) / gsz; return true;
}
struct Sched {
    int nM, nN, G, c, nseg;
    const char* A[2]; const char* B[2];
    int lda, ldb;
    int acol_mul, acol_shift;
    unsigned apan[2];
    __device__ __forceinline__ bool next(int i, Unit& u) const {
        const int ti = i / nseg; u.seg = i - ti * nseg;
        return tile_of(ti * G + c, nM, nN, u);
    }
    __device__ __forceinline__ const char* aptr(const Unit& u) const { return (u.seg ? A[1] : A[0]) + (size_t)u.pm * (u.seg ? apan[1] : apan[0]) + (size_t)acol_mul * (u.pn >> acol_shift) * 2; }
    __device__ __forceinline__ const char* bptr(const Unit& u) const { return (u.seg ? B[1] : B[0]) + ((size_t)u.pn * BM * ldb) * 2; }
};

__device__ __forceinline__ int pair_pm(int p, int G) { return G == 256 ? 8 * (p & 7) + ((p >> 3) & 7) : p >> 2; }
__device__ __forceinline__ int pair_g(int p, int G) { return G == 256 ? p >> 6 : p & 3; }
struct SchedRnn {
    int G, c; const char* A; const char* B; int lda, ldb;
    __device__ __forceinline__ bool next(int i, Unit& u) const { const int p = (i >> 1) * G + c; if (p >= 256) return false; u.pm = pair_pm(p, G); u.pn = pair_g(p, G) * 2 + (i & 1); u.seg = 0; return true; }
    __device__ __forceinline__ const char* aptr(const Unit& u) const { return A + ((size_t)u.pm * PANEL_ELEMS + (size_t)256 * (u.pn >> 1)) * 2; }
    __device__ __forceinline__ const char* bptr(const Unit& u) const { return B + ((size_t)u.pn * BM * ldb) * 2; }
};

template <class Epi, class SchedT, bool ALIGN_EPI, bool SP2>
__device__ __forceinline__ void gemm_phase(LAS unsigned char* lds, const SchedT& S, int K, const Epi& E, int wave_s) {
    const int tid = tid_from_wave(wave_s), wid = wave_s, lane = tid & 63, wr = wid >> 2, wc = wid & 3, fr = lane & 15, fq = lane >> 4;
    const int nt = K / BK;
    unsigned voffA[2], voffB[2];
#pragma unroll
    for (int i = 0; i < 2; ++i) { int R, C; stage_rc(tid * 16 + i * 8192, R, C); const int Rb = Epi::CC ? ((R >> 5) * 64 + perm32(R & 31)) : Epi::PERM ? ((R & ~31) + perm32(R & 31)) : R;
        voffA[i] = (unsigned)(R * S.lda + C) * 2u; voffB[i] = (unsigned)(Rb * S.ldb + C) * 2u; }
    const size_t kstep = (size_t)(BK * 2);
    const size_t hstepA = (size_t)HALF * S.lda * 2, hstepB = (size_t)(Epi::CC ? 32 : HALF) * S.ldb * 2;
    const unsigned ldsw = (unsigned)wid * 1024u;
    const int aoff = lds_byte(wr * 64 + fr, fq * 8), boff = lds_byte(wc * 32 + fr, fq * 8);
#define PG8_SA(b, h) (((b) * 2 + (h)) * HTB)
#define PG8_SB(b, h) ((4 + (b) * 2 + (h)) * HTB)
#define PG8_STAGE(bufoff, gbase, voff) do { _Pragma("unroll") for (int _i = 0; _i < 2; ++_i) \
        __builtin_amdgcn_global_load_lds((const unsigned*)((const char*)(gbase) + (voff)[_i]), (LAS unsigned*)(lds + (bufoff) + ldsw + _i * 8192), 16, 0, 0); } while (0)
#define PG8_LDA(dst, b, h) do { _Pragma("unroll") for (int m = 0; m < 4; ++m) _Pragma("unroll") for (int k = 0; k < 2; ++k) dst[m][k] = *(const LAS bf16x8*)(lds + PG8_SA(b, h) + aoff + m * 2048 + k * 1024); } while (0)
#define PG8_LDB(dst, b, h) do { _Pragma("unroll") for (int n = 0; n < 2; ++n) _Pragma("unroll") for (int k = 0; k < 2; ++k) dst[n][k] = *(const LAS bf16x8*)(lds + PG8_SB(b, h) + boff + n * 2048 + k * 1024); } while (0)
#define PG8_MMA(ai, bj, At, Bt) do { __builtin_amdgcn_s_setprio(1); _Pragma("unroll") for (int m = 0; m < 4; ++m) _Pragma("unroll") for (int n = 0; n < 2; ++n) _Pragma("unroll") for (int k = 0; k < 2; ++k) \
        acc[ai][bj][m][n] = __builtin_amdgcn_mfma_f32_16x16x32_bf16(Bt[n][k], At[m][k], acc[ai][bj][m][n], 0, 0, 0); __builtin_amdgcn_s_setprio(0); } while (0)
#define PG8_WAIT_V(n) asm volatile("s_waitcnt vmcnt(" #n ")" ::: "memory")
#define PG8_WAIT_L(n) asm volatile("s_waitcnt lgkmcnt(" #n ")" ::: "memory")
#define PG8_BAR __builtin_amdgcn_s_barrier()
#define PG8_SCHED __builtin_amdgcn_sched_barrier(0)
    Unit cur, nxt; int ui = 0;
    if (!S.next(0, cur)) return;
    f32x4 acc[2][2][4][2];
    E.init(acc, cur, wc, fq);
    bf16x8 At[4][2], B0[2][2], B1[2][2];
    const char* cA = S.aptr(cur); const char* cB = S.bptr(cur);
    if (PREFETCH_EPI) E.prefetch(cur, lds, tid);
    if constexpr (SP2) {
        PG8_STAGE(PG8_SB(0, 0), cB, voffB); PG8_STAGE(PG8_SB(0, 1), cB + hstepB, voffB); PG8_STAGE(PG8_SA(0, 0), cA, voffA); PG8_STAGE(PG8_SA(0, 1), cA + hstepA, voffA);
        if (wr == 1) PG8_BAR;
        PG8_WAIT_V(2); PG8_BAR;
        PG8_STAGE(PG8_SB(1, 0), cB + kstep, voffB); PG8_STAGE(PG8_SA(1, 0), cA + kstep, voffA); PG8_STAGE(PG8_SB(1, 1), cB + hstepB + kstep, voffB);
        PG8_WAIT_V(6); PG8_BAR;
    } else {
        PG8_STAGE(PG8_SB(0, 0), cB, voffB); PG8_STAGE(PG8_SA(0, 0), cA, voffA); PG8_STAGE(PG8_SB(0, 1), cB + hstepB, voffB); PG8_STAGE(PG8_SA(0, 1), cA + hstepA, voffA);
        if (wr == 1) PG8_BAR;
        PG8_WAIT_V(4); PG8_BAR;
        PG8_STAGE(PG8_SB(1, 0), cB + kstep, voffB); PG8_STAGE(PG8_SA(1, 0), cA + kstep, voffA); PG8_STAGE(PG8_SB(1, 1), cB + hstepB + kstep, voffB);
        PG8_WAIT_V(6); PG8_BAR;
    }
    for (;;) {
        const bool has_next = S.next(ui + 1, nxt);
        const char* nA = has_next ? S.aptr(nxt) : cA; const char* nB = has_next ? S.bptr(nxt) : cB;
        for (int t = 0; t < nt; t += 2) {
            const bool last = (t == nt - 2);
            const char* a1 = cA + (size_t)(t + 1) * kstep;
            const char* a2 = last ? nA : cA + (size_t)(t + 2) * kstep; const char* b2 = last ? nB : cB + (size_t)(t + 2) * kstep;
            const char* a3 = a2 + kstep; const char* b3 = b2 + kstep;
            if constexpr (SP2) {
            PG8_LDB(B0, 0, 0); PG8_LDB(B1, 0, 1); PG8_SCHED; PG8_LDA(At, 0, 0); PG8_STAGE(PG8_SA(1, 1), a1 + hstepA, voffA);
            PG8_WAIT_V(8); PG8_WAIT_L(0); PG8_BAR; PG8_MMA(0, 0, At, B0); PG8_MMA(0, 1, At, B1); PG8_BAR; PG8_SCHED;
            PG8_LDA(At, 0, 1); PG8_STAGE(PG8_SB(0, 0), b2, voffB); PG8_STAGE(PG8_SB(0, 1), b2 + hstepB, voffB); PG8_STAGE(PG8_SA(0, 0), a2, voffA);
            PG8_WAIT_V(8); PG8_WAIT_L(0); PG8_BAR; PG8_MMA(1, 0, At, B0); PG8_MMA(1, 1, At, B1); PG8_BAR; PG8_SCHED;
            PG8_LDB(B0, 1, 0); PG8_LDB(B1, 1, 1); PG8_SCHED; PG8_LDA(At, 1, 0); PG8_STAGE(PG8_SA(0, 1), a2 + hstepA, voffA);
            PG8_WAIT_V(8); PG8_WAIT_L(0); PG8_BAR; PG8_MMA(0, 0, At, B0); PG8_MMA(0, 1, At, B1); PG8_BAR; PG8_SCHED;
            PG8_LDA(At, 1, 1); PG8_STAGE(PG8_SB(1, 0), b3, voffB); PG8_STAGE(PG8_SB(1, 1), b3 + hstepB, voffB); PG8_STAGE(PG8_SA(1, 0), a3, voffA);
            PG8_WAIT_V(8); PG8_WAIT_L(0); PG8_BAR; PG8_MMA(1, 0, At, B0); PG8_MMA(1, 1, At, B1); PG8_BAR; PG8_SCHED;
            } else {
            PG8_LDB(B0, 0, 0); PG8_SCHED; PG8_LDA(At, 0, 0); PG8_STAGE(PG8_SA(1, 1), a1 + hstepA, voffA);
            PG8_WAIT_L(8); PG8_BAR; PG8_WAIT_L(0); PG8_MMA(0, 0, At, B0); PG8_BAR; PG8_SCHED;
            PG8_LDB(B1, 0, 1); PG8_STAGE(PG8_SB(0, 0), b2, voffB);
            PG8_BAR; PG8_WAIT_L(0); PG8_MMA(0, 1, At, B1); PG8_BAR;
            PG8_LDA(At, 0, 1); PG8_STAGE(PG8_SA(0, 0), a2, voffA);
            PG8_BAR; PG8_WAIT_L(0); PG8_MMA(1, 0, At, B0); PG8_BAR; PG8_SCHED;
            PG8_STAGE(PG8_SB(0, 1), b2 + hstepB, voffB);
            PG8_WAIT_V(6); PG8_BAR; PG8_MMA(1, 1, At, B1); PG8_BAR;
            PG8_LDB(B0, 1, 0); PG8_SCHED; PG8_LDA(At, 1, 0); PG8_STAGE(PG8_SA(0, 1), a2 + hstepA, voffA);
            PG8_WAIT_L(8); PG8_BAR; PG8_WAIT_L(0); PG8_MMA(0, 0, At, B0); PG8_BAR; PG8_SCHED;
            PG8_LDB(B1, 1, 1); PG8_STAGE(PG8_SB(1, 0), b3, voffB);
            PG8_BAR; PG8_WAIT_L(0); PG8_MMA(0, 1, At, B1); PG8_BAR;
            PG8_LDA(At, 1, 1); PG8_STAGE(PG8_SA(1, 0), a3, voffA);
            PG8_BAR; PG8_WAIT_L(0); PG8_MMA(1, 0, At, B0); PG8_BAR; PG8_SCHED;
            PG8_STAGE(PG8_SB(1, 1), b3 + hstepB, voffB);
            PG8_WAIT_V(6); PG8_BAR; PG8_MMA(1, 1, At, B1); PG8_BAR;
            }
        }
        if constexpr (ALIGN_EPI) { if (wr == 0) PG8_BAR; }
        { int fr_e = fr, fq_e = fq; asm volatile("" : "+v"(fr_e), "+v"(fq_e));
          E(acc, cur, wr, wc, fr_e, fq_e, lds); }
        if (!has_next) break;
        if (E.zero_after(cur)) E.init(acc, nxt, wc, fq);
        cur = nxt; cA = nA; cB = nB; ++ui;
        if constexpr (ALIGN_EPI) { if (wr == 1) PG8_BAR; }
    }
    PG8_WAIT_V(0);
    if constexpr (!ALIGN_EPI) { if (wr == 0) PG8_BAR; }
    PG8_BAR;
#undef PG8_SA
#undef PG8_SB
#undef PG8_STAGE
#undef PG8_LDA
#undef PG8_LDB
#undef PG8_MMA
#undef PG8_WAIT_V
#undef PG8_WAIT_L
#undef PG8_BAR
#undef PG8_SCHED
}

template <int CTRL> __device__ __forceinline__ float dpp_mov(float old, float v) {
    return __builtin_bit_cast(float, __builtin_amdgcn_update_dpp(__builtin_bit_cast(int, old), __builtin_bit_cast(int, v), CTRL, 0xf, 0xf, false)); }
template <int K> __device__ __forceinline__ float row_above(float cur, float prev) { return dpp_mov<0x110 + K>(dpp_mov<0x100 + 16 - K>(0.0f, prev), cur); }
struct EpiProj {
    static constexpr bool PERM = true, CC = false;
    __device__ __forceinline__ void prefetch(const Unit&, LAS unsigned char*, int) const {}
    bf16_t* O; size_t split_stride;
    unsigned* wrdy;
    const float* conv_w; const float* conv_b; bf16_t* XH;
    __device__ __forceinline__ bool zero_after(const Unit&) const { return true; }
    __device__ __forceinline__ void init(f32x4 (&acc)[2][2][4][2], const Unit&, int, int) const {
#pragma unroll
        for (int a = 0; a < 2; ++a)
#pragma unroll
            for (int b = 0; b < 2; ++b)
#pragma unroll
                for (int m = 0; m < 4; ++m)
#pragma unroll
                    for (int n = 0; n < 2; ++n) acc[a][b][m][n] = (f32x4){0.f, 0.f, 0.f, 0.f}; }
    __device__ __forceinline__ void conv_tile(f32x4 (&acc)[2][2][4][2], const Unit& u, int wr, int wc, int fr, int fq, LAS unsigned char* lds) const {
        LAS float* E = (LAS float*)(lds + 131072);
        const int colw = wc * 32 + 8 * fq, cg = (u.pn & 3) * BM;
        if (wr == 0 && fr < 3) {
#pragma unroll
            for (int bj = 0; bj < 2; ++bj) { const f32x4 v0 = acc[0][bj][0][0], v1 = acc[0][bj][0][1]; u32x4 w; w.x = cvt_pk_bf16(v0[0], v0[1]); w.y = cvt_pk_bf16(v0[2], v0[3]); w.z = cvt_pk_bf16(v1[0], v1[1]); w.w = cvt_pk_bf16(v1[2], v1[3]);
                *(u32x4*)(XH + (size_t)(u.pm * 6 + fr) * 1024 + cg + bj * HALF + colw) = w; } }
        if (wr == 1 && fr >= 13) {
#pragma unroll
            for (int bj = 0; bj < 2; ++bj) { const f32x4 v0 = acc[1][bj][3][0], v1 = acc[1][bj][3][1]; u32x4 w; w.x = cvt_pk_bf16(v0[0], v0[1]); w.y = cvt_pk_bf16(v0[2], v0[3]); w.z = cvt_pk_bf16(v1[0], v1[1]); w.w = cvt_pk_bf16(v1[2], v1[3]);
                *(u32x4*)(XH + (size_t)(u.pm * 6 + 3 + fr - 13) * 1024 + cg + bj * HALF + colw) = w; } }
        if (fr >= 13) {
#pragma unroll
            for (int ai = 0; ai < 2; ++ai)
#pragma unroll
                for (int bj = 0; bj < 2; ++bj)
#pragma unroll
                    for (int n = 0; n < 2; ++n) *(LAS f32x4*)(E + ((2 * ai + wr) * 3 + (fr - 13)) * 256 + bj * HALF + colw + 4 * n) = acc[ai][bj][3][n]; }
        asm volatile("s_waitcnt lgkmcnt(0)" ::: "memory"); __builtin_amdgcn_s_barrier(); asm volatile("" ::: "memory");
        const int frc = fr >= 13 ? fr - 13 : 0;
        f32x4 cw[2][2][5];
#pragma unroll
        for (int bj = 0; bj < 2; ++bj)
#pragma unroll
            for (int n = 0; n < 2; ++n) { const int c = cg + bj * HALF + colw + 4 * n;
#pragma unroll
                for (int j = 0; j < 4; ++j) cw[bj][n][j] = *(const f32x4*)(conv_w + j * 1024 + c);
                cw[bj][n][4] = *(const f32x4*)(conv_b + c); }
#pragma unroll
        for (int bj = 0; bj < 2; ++bj)
#pragma unroll
            for (int n = 0; n < 2; ++n) {
                const f32x4 w0 = cw[bj][n][0], w1 = cw[bj][n][1], w2 = cw[bj][n][2], w3 = cw[bj][n][3], bb = cw[bj][n][4];
#pragma unroll
                for (int ai = 0; ai < 2; ++ai) { const int g4 = 2 * ai + wr;
                    f32x4 pv = (f32x4){0.f, 0.f, 0.f, 0.f};
                    if (g4 > 0) pv = *(const LAS f32x4*)(E + ((g4 - 1) * 3 + frc) * 256 + bj * HALF + colw + 4 * n);
#define CONV_STEP(M_, PREV_) { const float cur = acc[ai][bj][M_][n][e], prev = (PREV_); float r = bb[e] + w3[e] * cur; \
                            asm volatile("s_nop 1\n\tv_fmac_f32_dpp %0, %1, %3 row_shr:1 row_mask:0xf bank_mask:0xf\n\tv_fmac_f32_dpp %0, %2, %3 row_shl:15 row_mask:0xf bank_mask:0xf\n\t" \
                                         "v_fmac_f32_dpp %0, %1, %4 row_shr:2 row_mask:0xf bank_mask:0xf\n\tv_fmac_f32_dpp %0, %2, %4 row_shl:14 row_mask:0xf bank_mask:0xf\n\t" \
                                         "v_fmac_f32_dpp %0, %1, %5 row_shr:3 row_mask:0xf bank_mask:0xf\n\tv_fmac_f32_dpp %0, %2, %5 row_shl:13 row_mask:0xf bank_mask:0xf" \
                                         : "+v"(r) : "v"(cur), "v"(prev), "v"(w2[e]), "v"(w1[e]), "v"(w0[e])); \
                            acc[ai][bj][M_][n][e] = r; }
#pragma unroll
                    for (int e = 0; e < 4; ++e) {
                        CONV_STEP(3, acc[ai][bj][2][n][e]) CONV_STEP(2, acc[ai][bj][1][n][e]) CONV_STEP(1, acc[ai][bj][0][n][e]) CONV_STEP(0, pv[e])
                        asm volatile("" : "+v"(acc[ai][bj][0][n][e]), "+v"(acc[ai][bj][1][n][e]), "+v"(acc[ai][bj][2][n][e]), "+v"(acc[ai][bj][3][n][e])); }
#undef CONV_STEP
                } }
    }
    __device__ __forceinline__ void operator()(f32x4 (&acc)[2][2][4][2], const Unit& u, int wr, int wc, int fr, int fq, LAS unsigned char* lds) const {
        const int row0 = wr * 64 + fr; const int t = u.pn >> 2; bf16_t* base = O + (size_t)t * split_stride + (size_t)u.pm * PANEL_ELEMS;
        const int col0 = (u.pn & 3) * BM + wc * 32 + 8 * fq;
        if (t == 0) conv_tile(acc, u, wr, wc, fr, fq, lds);
#pragma unroll
        for (int ai = 0; ai < 2; ++ai)
#pragma unroll
            for (int m = 0; m < 4; ++m) { bf16_t* rowp = base + (size_t)(row0 + ai * HALF + m * 16) * 1024 + col0;
#pragma unroll
                for (int bj = 0; bj < 2; ++bj) { const f32x4 v0 = acc[ai][bj][m][0], v1 = acc[ai][bj][m][1];
                    u32x4 w; w.x = cvt_pk_bf16(v0[0], v0[1]); w.y = cvt_pk_bf16(v0[2], v0[3]); w.z = cvt_pk_bf16(v1[0], v1[1]); w.w = cvt_pk_bf16(v1[2], v1[3]);
                    *(u32x4*)(rowp + bj * HALF) = w; } }
        if (t == 1 && wrdy != nullptr && wr == 0 && wc == 0 && fr == 0 && fq == 0) {
            __builtin_amdgcn_fence(__ATOMIC_RELEASE, "agent"); asm volatile("s_waitcnt vmcnt(0)" ::: "memory");
            __hip_atomic_fetch_add(wrdy, 1u, __ATOMIC_RELAXED, __HIP_MEMORY_SCOPE_AGENT); }
    }
};
__device__ __forceinline__ f32x4 ex2_4(f32x4 v) { return (f32x4){__builtin_amdgcn_exp2f(v[0]), __builtin_amdgcn_exp2f(v[1]), __builtin_amdgcn_exp2f(v[2]), __builtin_amdgcn_exp2f(v[3])}; }
__device__ __forceinline__ f32x4 rcp4(f32x4 v) { return (f32x4){__builtin_amdgcn_rcpf(v[0]), __builtin_amdgcn_rcpf(v[1]), __builtin_amdgcn_rcpf(v[2]), __builtin_amdgcn_rcpf(v[3])}; }
__device__ __forceinline__ f32x4 sqrt4(f32x4 v) { return (f32x4){__builtin_amdgcn_sqrtf(v[0]), __builtin_amdgcn_sqrtf(v[1]), __builtin_amdgcn_sqrtf(v[2]), __builtin_amdgcn_sqrtf(v[3])}; }
template <int K> __device__ __forceinline__ float dpp_row_shr(float old, float v) {
    return __builtin_bit_cast(float, __builtin_amdgcn_update_dpp(__builtin_bit_cast(int, old), __builtin_bit_cast(int, v), 0x110 + K, 0xf, 0xf, false)); }
__device__ __forceinline__ float bcast15(float v, int) { return __builtin_bit_cast(float, __builtin_amdgcn_update_dpp(0, __builtin_bit_cast(int, v), 0x15F, 0xf, 0xf, false)); }
struct EpiRnn {
    static constexpr bool PERM = true, CC = false;
    __device__ __forceinline__ void prefetch(const Unit&, LAS unsigned char*, int) const {}
    const bf16_t* XR; bf16_t* Y; bf16_t* Yo; const float* b_a; const float* b_x; const float* spt;
    unsigned long long* SUM; unsigned* CNT; unsigned* tmo;
    __device__ __forceinline__ bool zero_after(const Unit&) const { return true; }
    __device__ __forceinline__ void init(f32x4 (&acc)[2][2][4][2], const Unit& u, int wc, int fq) const {
        int ch0 = u.pn * 128 + wc * 32 + 8 * fq; asm volatile("" : "+v"(ch0));
#pragma unroll
        for (int n = 0; n < 2; ++n) { const f32x4 ba = *(const f32x4*)(b_a + ch0 + 4 * n) * -1.44269504089f, bx = *(const f32x4*)(b_x + ch0 + 4 * n) * -1.44269504089f;
#pragma unroll
            for (int ai = 0; ai < 2; ++ai)
#pragma unroll
                for (int m = 0; m < 4; ++m) { acc[ai][0][m][n] = ba; acc[ai][1][m][n] = bx; } } }
    __device__ __forceinline__ void operator()(f32x4 (&acc)[2][2][4][2], const Unit& u, int wr, int wc, int fr, int fq, LAS unsigned char* lds) const {
        LAS f32x2* T = (LAS f32x2*)(lds + 131072);
        LAS float* Hin = (LAS float*)(lds + 131072 + 4096);
        LAS unsigned* flag = (LAS unsigned*)(lds + 131072 + 4096 + 512);
        const int lane = fq * 16 + fr, wid = wr * 4 + wc, tid = wid * 64 + lane;
        const int bb = u.pm >> 4, cc = u.pm & 15, g2 = u.pn;
        const int colw = wc * 32 + 8 * fq;
        int ch0 = g2 * 128 + colw; asm volatile("" : "+v"(ch0));
        const int row0 = u.pm * BM + wr * 64 + fr;
        {
            f32x4 sp[2];
#pragma unroll
            for (int n = 0; n < 2; ++n) sp[n] = *(const f32x4*)(spt + ch0 + 4 * n);
            u32x4 xw8[2][4];
#pragma unroll
            for (int ai = 0; ai < 2; ++ai)
#pragma unroll
                for (int m = 0; m < 4; ++m) xw8[ai][m] = *(const u32x4*)(XR + (prow(row0 + ai * HALF + m * 16) + (unsigned)ch0));
#pragma unroll
            for (int ai = 0; ai < 2; ++ai)
#pragma unroll
                for (int m = 0; m < 4; ++m) { const int row = row0 + ai * HALF + m * 16; const bool first = (row & (SEQ - 1)) == 0;
                    const u32x4 xw = xw8[ai][m];
                    const f32x4 xv[2] = {(f32x4){bflo(xw.x), bfhi(xw.x), bflo(xw.y), bfhi(xw.y)}, (f32x4){bflo(xw.z), bfhi(xw.z), bflo(xw.w), bfhi(xw.w)}};
#pragma unroll
                    for (int n = 0; n < 2; ++n) { const f32x4 r = rcp4(ex2_4(acc[ai][0][m][n]) + 1.0f), ig = rcp4(ex2_4(acc[ai][1][m][n]) + 1.0f);
                        const f32x4 av = ex2_4(sp[n] * r); const f32x4 t = __builtin_elementwise_abs(1.0f - av * av);
                        const f32x4 mult = (ai == 0 && m == 0 && first) ? (f32x4){1.f, 1.f, 1.f, 1.f} : sqrt4(t);
                        acc[ai][0][m][n] = av; acc[ai][1][m][n] = xv[n] * ig * mult; asm volatile("" : "+v"(acc[ai][0][m][n]), "+v"(acc[ai][1][m][n])); } }
        }
        const int src15 = ((lane & 48) | 15) * 4;
#pragma unroll
        for (int ai = 0; ai < 2; ++ai)
#pragma unroll
            for (int n = 0; n < 2; ++n)
#pragma unroll
                for (int e = 0; e < 4; e += 2) {
#pragma unroll
                    for (int m = 0; m < 4; ++m) { float A0 = acc[ai][0][m][n][e], B0 = acc[ai][1][m][n][e], A1 = acc[ai][0][m][n][e + 1], B1 = acc[ai][1][m][n][e + 1];
#define RNN_SCAN_STEP2(KS) "v_fmac_f32_dpp %0, %0, %1 row_shr:" #KS " row_mask:0xf bank_mask:0xf\n\tv_fmac_f32_dpp %2, %2, %3 row_shr:" #KS " row_mask:0xf bank_mask:0xf\n\t" \
                           "v_mul_f32_dpp %1, %1, %1 row_shr:" #KS " row_mask:0xf bank_mask:0xf\n\tv_mul_f32_dpp %3, %3, %3 row_shr:" #KS " row_mask:0xf bank_mask:0xf\n\t"
                        asm volatile("s_nop 1\n\t" RNN_SCAN_STEP2(1) RNN_SCAN_STEP2(2) RNN_SCAN_STEP2(4) RNN_SCAN_STEP2(8) : "+v"(B0), "+v"(A0), "+v"(B1), "+v"(A1));
#undef RNN_SCAN_STEP2
                        acc[ai][0][m][n][e] = A0; acc[ai][1][m][n][e] = B0; acc[ai][0][m][n][e + 1] = A1; acc[ai][1][m][n][e + 1] = B1; }
#pragma unroll
                    for (int ee = e; ee < e + 2; ++ee) {
                        float Af[3], Bf[3];
#pragma unroll
                        for (int m = 0; m < 3; ++m) { Af[m] = bcast15(acc[ai][0][m][n][ee], src15); Bf[m] = bcast15(acc[ai][1][m][n][ee], src15); }
                        float Ac = Af[0], Hc = Bf[0];
#pragma unroll
                        for (int m = 1; m < 4; ++m) { const float A = acc[ai][0][m][n][ee];
                            acc[ai][1][m][n][ee] = A * Hc + acc[ai][1][m][n][ee]; acc[ai][0][m][n][ee] = A * Ac;
                            if (m < 3) { Hc = Af[m] * Hc + Bf[m]; Ac = Af[m] * Ac; } }
                        asm volatile("" : "+v"(acc[ai][0][1][n][ee]), "+v"(acc[ai][1][1][n][ee]), "+v"(acc[ai][0][2][n][ee]), "+v"(acc[ai][1][2][n][ee]), "+v"(acc[ai][0][3][n][ee]), "+v"(acc[ai][1][3][n][ee])); } }
        if (fr == 15) {
#pragma unroll
            for (int ai = 0; ai < 2; ++ai)
#pragma unroll
                for (int n = 0; n < 2; ++n)
#pragma unroll
                    for (int e = 0; e < 4; ++e) T[(2 * ai + wr) * 128 + colw + 4 * n + e] = (f32x2){acc[ai][0][3][n][e], acc[ai][1][3][n][e]};
        }
        asm volatile("s_waitcnt lgkmcnt(0)" ::: "memory"); __builtin_amdgcn_s_barrier(); asm volatile("" ::: "memory");
        f32x2 tq[3][2][4];
#pragma unroll
        for (int n = 0; n < 2; ++n)
#pragma unroll
            for (int e = 0; e < 4; ++e) { const int col = colw + 4 * n + e; tq[0][n][e] = T[col]; tq[1][n][e] = T[128 + col]; tq[2][n][e] = T[256 + col]; }
        asm volatile("s_waitcnt lgkmcnt(0)" ::: "memory");
#pragma unroll
        for (int n = 0; n < 2; ++n)
#pragma unroll
            for (int e = 0; e < 4; ++e) {
                const f32x2 t0 = tq[0][n][e], t1 = tq[1][n][e], t2 = tq[2][n][e];
                const f32x2 c2 = (f32x2){t1.x * t0.x, t1.x * t0.y + t1.y}, c3 = (f32x2){t2.x * c2.x, t2.x * c2.y + t2.y};
                const f32x2 k0 = wr == 0 ? (f32x2){1.0f, 0.0f} : t0, k1 = wr == 0 ? c2 : c3;
#pragma unroll
                for (int m = 0; m < 4; ++m) { { const float A = acc[0][0][m][n][e]; acc[0][1][m][n][e] = A * k0.y + acc[0][1][m][n][e]; acc[0][0][m][n][e] = A * k0.x; }
                                              { const float A = acc[1][0][m][n][e]; acc[1][1][m][n][e] = A * k1.y + acc[1][1][m][n][e]; acc[1][0][m][n][e] = A * k1.x; } } }
        if (wr == 1 && fr == 15) {
            unsigned long long* slot = SUM + ((size_t)((bb * 16 + cc) * 8 + g2)) * 128 + colw;
#pragma unroll
            for (int n = 0; n < 2; ++n)
#pragma unroll
                for (int e = 0; e < 4; ++e) __hip_atomic_store(slot + 4 * n + e, ((unsigned long long)__float_as_uint(acc[1][1][3][n][e]) << 32) | __float_as_uint(acc[1][0][3][n][e]), __ATOMIC_RELAXED, __HIP_MEMORY_SCOPE_AGENT);
        }
        asm volatile("s_waitcnt vmcnt(0)" ::: "memory");
        if (wr == 1 && lane == 0) __hip_atomic_fetch_add(CNT + 64 * ((bb * 8 + g2) * 16 + cc), 1u, __ATOMIC_RELAXED, __HIP_MEMORY_SCOPE_AGENT);
        if (wid == 0) {
            bool dead = false;
            if (lane < cc) { unsigned sp = 0u;
                while (__hip_atomic_load(CNT + 64 * ((bb * 8 + g2) * 16 + lane), __ATOMIC_RELAXED, __HIP_MEMORY_SCOPE_AGENT) < 4u) {
                    if (++sp > (1u << 20)) { __hip_atomic_store(tmo, 1u, __ATOMIC_RELAXED, __HIP_MEMORY_SCOPE_AGENT); dead = true; break; }
                    __builtin_amdgcn_s_sleep(1); } }
            __builtin_amdgcn_fence(__ATOMIC_ACQUIRE, "agent");
            if (lane == 0) flag[0] = dead ? 1u : 0u;
        }
        asm volatile("s_waitcnt vmcnt(0) lgkmcnt(0)" ::: "memory"); __builtin_amdgcn_s_barrier(); asm volatile("" ::: "memory");
        if (tid < 128) {
            unsigned long long w[15];
#pragma unroll
            for (int c2 = 0; c2 < 15; ++c2) w[c2] = __hip_atomic_load(SUM + ((size_t)((bb * 16 + c2) * 8 + g2)) * 128 + tid, __ATOMIC_RELAXED, __HIP_MEMORY_SCOPE_AGENT);
            float H = 0.f;
#pragma unroll
            for (int c2 = 0; c2 < 15; ++c2) { const float A = c2 < cc ? __uint_as_float((unsigned)w[c2]) : 1.0f, Hc = c2 < cc ? __uint_as_float((unsigned)(w[c2] >> 32)) : 0.0f; H = A * H + Hc; }
            Hin[tid] = H; }
        asm volatile("s_waitcnt lgkmcnt(0)" ::: "memory"); __builtin_amdgcn_s_barrier(); asm volatile("" ::: "memory");
        const f32x4 hin[2] = {*(const LAS f32x4*)(Hin + colw), *(const LAS f32x4*)(Hin + colw + 4)};
        u32x4 yw8[2][4];
#pragma unroll
        for (int ai = 0; ai < 2; ++ai)
#pragma unroll
            for (int m = 0; m < 4; ++m) yw8[ai][m] = *(const u32x4*)(Y + (size_t)u.pm * PANEL_ELEMS + ((unsigned)(wr * 64 + fr + ai * HALF + m * 16) * 1024u + (unsigned)ch0));
#pragma unroll
        for (int ai = 0; ai < 2; ++ai)
#pragma unroll
            for (int m = 0; m < 4; ++m) { bf16_t* yp = Y + (size_t)u.pm * PANEL_ELEMS + ((unsigned)(wr * 64 + fr + ai * HALF + m * 16) * 1024u + (unsigned)ch0);
                const u32x4 yw = yw8[ai][m];
                const f32x4 yv[2] = {(f32x4){bflo(yw.x), bfhi(yw.x), bflo(yw.y), bfhi(yw.y)}, (f32x4){bflo(yw.z), bfhi(yw.z), bflo(yw.w), bfhi(yw.w)}};
                f32x4 o[2];
#pragma unroll
                for (int n = 0; n < 2; ++n) { const f32x4 y = yv[n], hr = acc[ai][1][m][n] + acc[ai][0][m][n] * hin[n];
                    const f32x4 uu = y * (y * y * 0.044715f + 1.0f); const f32x4 g = y * rcp4(ex2_4(uu * (-1.5957691216f * 1.44269504089f)) + 1.0f);
                    o[n] = g * hr; }
                u32x4 w; w.x = cvt_pk_bf16(o[0][0], o[0][1]); w.y = cvt_pk_bf16(o[0][2], o[0][3]); w.z = cvt_pk_bf16(o[1][0], o[1][1]); w.w = cvt_pk_bf16(o[1][2], o[1][3]);
                *(u32x4*)yp = w; }
    }
};
struct EpiMerge {
    static constexpr bool PERM = true, CC = false;
    __device__ __forceinline__ void prefetch(const Unit&, LAS unsigned char*, int) const {}
    const bf16_t* GA; const bf16_t* GB; bf16_t* O;
    __device__ __forceinline__ bool zero_after(const Unit& u) const { return u.seg != 0; }
    __device__ __forceinline__ void init(f32x4 (&acc)[2][2][4][2], const Unit&, int, int) const {
#pragma unroll
        for (int a = 0; a < 2; ++a)
#pragma unroll
            for (int b = 0; b < 2; ++b)
#pragma unroll
                for (int m = 0; m < 4; ++m)
#pragma unroll
                    for (int n = 0; n < 2; ++n) acc[a][b][m][n] = (f32x4){0.f, 0.f, 0.f, 0.f}; }
    __device__ __forceinline__ void operator()(f32x4 (&acc)[2][2][4][2], const Unit& u, int wr, int wc, int fr, int fq, LAS unsigned char*) const {
        const int row0 = u.pm * BM + wr * 64 + fr, col0 = u.pn * BM + wc * 32 + 8 * fq;
#define GOFF(ai_, m_, bj_) (prow(row0 + (ai_) * HALF + (m_) * 16) + (unsigned)(col0 + (bj_) * HALF))
#define UNPK8(v_, f_) const float f_[8] = {bflo((v_).x), bfhi((v_).x), bflo((v_).y), bfhi((v_).y), bflo((v_).z), bfhi((v_).z), bflo((v_).w), bfhi((v_).w)}
        if (u.seg == 0) {
            u32x4 gw[2][2][2][2];
#define MG_LOAD(q_) do { const int ai_ = (q_) >> 1, m0_ = ((q_) & 1) * 2; _Pragma("unroll") for (int mm = 0; mm < 2; ++mm) _Pragma("unroll") for (int bj = 0; bj < 2; ++bj) { \
                gw[(q_) & 1][0][mm][bj] = *(const u32x4*)(GB + GOFF(ai_, m0_ + mm, bj)); gw[(q_) & 1][1][mm][bj] = *(const u32x4*)(GA + GOFF(ai_, m0_ + mm, bj)); } } while (0)
            MG_LOAD(0);
#pragma unroll
            for (int q = 0; q < 4; ++q) { const int ai = q >> 1, m0 = (q & 1) * 2;
                if (q < 3) MG_LOAD(q + 1);
#pragma unroll
                for (int mm = 0; mm < 2; ++mm)
#pragma unroll
                    for (int bj = 0; bj < 2; ++bj) { UNPK8(gw[q & 1][0][mm][bj], gbv); UNPK8(gw[q & 1][1][mm][bj], gav);
#pragma unroll
                        for (int j = 0; j < 8; ++j) { const float eb = fast_exp(-vmax1(gbv[j], -30.f)), ea = fast_exp(-gav[j]);
                            acc[ai][bj][m0 + mm][j >> 2][j & 3] *= (1.0f + eb) * __builtin_amdgcn_rcpf(1.0f + ea); } }
                asm volatile("" ::: "memory"); }
#undef MG_LOAD
        } else {
#pragma unroll
            for (int ai = 0; ai < 2; ++ai) { u32x4 gbw[4][2];
#pragma unroll
                for (int m = 0; m < 4; ++m)
#pragma unroll
                    for (int bj = 0; bj < 2; ++bj) gbw[m][bj] = *(const u32x4*)(GB + GOFF(ai, m, bj));
#pragma unroll
                for (int m = 0; m < 4; ++m)
#pragma unroll
                    for (int bj = 0; bj < 2; ++bj) { UNPK8(gbw[m][bj], gbv);
                        float o[8];
#pragma unroll
                        for (int j = 0; j < 8; ++j) { const float eb = fast_exp(-vmax1(gbv[j], -30.f)); o[j] = acc[ai][bj][m][j >> 2][j & 3] * __builtin_amdgcn_rcpf(1.0f + eb); }
                        u32x4 w; w.x = cvt_pk_bf16(o[0], o[1]); w.y = cvt_pk_bf16(o[2], o[3]); w.z = cvt_pk_bf16(o[4], o[5]); w.w = cvt_pk_bf16(o[6], o[7]);
                        *(u32x4*)(O + GOFF(ai, m, bj)) = w; }
                asm volatile("" ::: "memory"); }
        }
#undef GOFF
#undef UNPK8
    }
};
struct EpiRes {
    static constexpr bool PERM = false, CC = false;
    __device__ __forceinline__ void prefetch(const Unit&, LAS unsigned char*, int) const {}
    const float* base; float* out; const float* gate;
    __device__ __forceinline__ bool zero_after(const Unit&) const { return true; }
    __device__ __forceinline__ void init(f32x4 (&acc)[2][2][4][2], const Unit&, int, int) const {
#pragma unroll
        for (int a = 0; a < 2; ++a)
#pragma unroll
            for (int b = 0; b < 2; ++b)
#pragma unroll
                for (int m = 0; m < 4; ++m)
#pragma unroll
                    for (int n = 0; n < 2; ++n) acc[a][b][m][n] = (f32x4){0.f, 0.f, 0.f, 0.f}; }
    __device__ __forceinline__ void operator()(f32x4 (&acc)[2][2][4][2], const Unit& u, int wr, int wc, int fr, int fq, LAS unsigned char*) const {
        const int row0 = u.pm * BM + wr * 64 + fr, col0 = u.pn * BM + wc * 32 + 4 * fq; const int b = u.pm >> 4;
        f32x4 gv[2][2];
#pragma unroll
        for (int bj = 0; bj < 2; ++bj)
#pragma unroll
            for (int n = 0; n < 2; ++n) gv[bj][n] = *(const f32x4*)(gate + (size_t)b * NMOD + col0 + bj * HALF + n * 16);
#pragma unroll
        for (int ai = 0; ai < 2; ++ai)
#pragma unroll
            for (int m = 0; m < 4; ++m) { const size_t off = (size_t)(row0 + ai * HALF + m * 16) * 1024 + col0;
#pragma unroll
                for (int bj = 0; bj < 2; ++bj)
#pragma unroll
                    for (int n = 0; n < 2; ++n) { const f32x4 bs = *(const f32x4*)(base + off + bj * HALF + n * 16); *(f32x4*)(out + off + bj * HALF + n * 16) = bs + gv[bj][n] * acc[ai][bj][m][n]; } }
    }
};
struct RmsStats {
    float* xbuf; unsigned* cnt; unsigned* tmo;
    struct NoAfter { __device__ __forceinline__ void operator()() const {} };
    template <class F = NoAfter> __device__ __forceinline__ void run(const f32x4 (&v)[2][2][4][2], const Unit& u, int wr, int wc, int fr, int fq, LAS unsigned char* scr, const F& after_publish = F()) const {
        LAS float* P = (LAS float*)scr;
        LAS float* S = (LAS float*)(scr + 4096);
        const int lane = fq * 16 + fr, wid = wr * 4 + wc;
#pragma unroll
        for (int ai = 0; ai < 2; ++ai)
#pragma unroll
            for (int m = 0; m < 4; ++m) { float q = 0.f;
#pragma unroll
                for (int bj = 0; bj < 2; ++bj)
#pragma unroll
                    for (int n = 0; n < 2; ++n) { const f32x4 x = v[ai][bj][m][n]; q += (x[0] * x[0] + x[1] * x[1]) + (x[2] * x[2] + x[3] * x[3]); }
                q = sum_rows4(q);
                if (fq == 0) P[(ai * HALF + wr * 64 + m * 16 + fr) * 4 + wc] = q; }
        asm volatile("s_waitcnt lgkmcnt(0)" ::: "memory"); __builtin_amdgcn_s_barrier(); asm volatile("" ::: "memory");
        const int row = wid * 32 + (lane & 31);
        if (lane < 32) { const f32x4 p = *(const LAS f32x4*)(P + row * 4);
            __hip_atomic_store(xbuf + (size_t)(u.pm * BM + row) * 4 + u.pn, (p.x + p.y) + (p.z + p.w), __ATOMIC_RELAXED, __HIP_MEMORY_SCOPE_AGENT); }
        asm volatile("s_waitcnt vmcnt(0)" ::: "memory");
        if (lane == 0) __hip_atomic_fetch_add(cnt + 64 * u.pm, 1u, __ATOMIC_RELAXED, __HIP_MEMORY_SCOPE_AGENT);
        after_publish();
        if (wid == 0) {
            unsigned sp = 0u;
            for (;;) {
                if ((unsigned)__builtin_amdgcn_readfirstlane(__hip_atomic_load(cnt + 64 * u.pm, __ATOMIC_RELAXED, __HIP_MEMORY_SCOPE_AGENT)) >= 32u) break;
                if (++sp > (1u << 20)) { if (lane == 0) __hip_atomic_store(tmo, 1u, __ATOMIC_RELAXED, __HIP_MEMORY_SCOPE_AGENT); break; }
                __builtin_amdgcn_s_sleep(1);
            }
            __builtin_amdgcn_fence(__ATOMIC_ACQUIRE, "agent");
        }
        asm volatile("s_waitcnt vmcnt(0) lgkmcnt(0)" ::: "memory"); __builtin_amdgcn_s_barrier(); asm volatile("" ::: "memory");
        if (lane < 32) { const float* slot = xbuf + (size_t)(u.pm * BM + row) * 4; float q = 0.f;
#pragma unroll
            for (int t = 0; t < 4; ++t) q += __hip_atomic_load(slot + t, __ATOMIC_RELAXED, __HIP_MEMORY_SCOPE_AGENT);
            S[row] = 1.0f / sqrtf(q * (1.0f / 1024.0f) + EPS); }
        asm volatile("s_waitcnt lgkmcnt(0)" ::: "memory"); __builtin_amdgcn_s_barrier(); asm volatile("" ::: "memory");
    }
};
struct EpiResNorm {
    static constexpr bool PERM = true, CC = false;
    __device__ __forceinline__ void prefetch(const Unit&, LAS unsigned char*, int) const {}
    const float* base; bf16_t* X1B; bf16_t* HN; const float* gate; const float* sc; const float* sh; const float* g; RmsStats st;
    __device__ __forceinline__ bool zero_after(const Unit&) const { return true; }
    __device__ __forceinline__ void init(f32x4 (&acc)[2][2][4][2], const Unit&, int, int) const {
#pragma unroll
        for (int a = 0; a < 2; ++a)
#pragma unroll
            for (int b = 0; b < 2; ++b)
#pragma unroll
                for (int m = 0; m < 4; ++m)
#pragma unroll
                    for (int n = 0; n < 2; ++n) acc[a][b][m][n] = (f32x4){0.f, 0.f, 0.f, 0.f}; }
    __device__ __forceinline__ void operator()(f32x4 (&acc)[2][2][4][2], const Unit& u, int wr, int wc, int fr, int fq, LAS unsigned char* lds) const {
        const int row0 = u.pm * BM + wr * 64 + fr, col0 = u.pn * BM + wc * 32 + 8 * fq; const int b = u.pm >> 4;
        f32x4 gvv[2][2];
#pragma unroll
        for (int bj = 0; bj < 2; ++bj) { gvv[bj][0] = *(const f32x4*)(gate + (size_t)b * NMOD + col0 + bj * HALF); gvv[bj][1] = *(const f32x4*)(gate + (size_t)b * NMOD + col0 + bj * HALF + 4); }
        f32x4 xq[2][4][2];
#define RX_LOAD(q_) do { const int bj_ = (q_) >> 1, ai_ = (q_) & 1; _Pragma("unroll") for (int m = 0; m < 4; ++m) { const unsigned off = (unsigned)(row0 + ai_ * HALF + m * 16) * 1024u + (unsigned)(col0 + bj_ * HALF); \
            xq[(q_) & 1][m][0] = *(const f32x4*)(base + off); xq[(q_) & 1][m][1] = *(const f32x4*)(base + off + 4); } } while (0)
        RX_LOAD(0);
#pragma unroll
        for (int q = 0; q < 4; ++q) { const int bj = q >> 1, ai = q & 1;
            if (q < 3) RX_LOAD(q + 1);
#pragma unroll
            for (int m = 0; m < 4; ++m) {
                acc[ai][bj][m][0] = xq[q & 1][m][0] + gvv[bj][0] * acc[ai][bj][m][0]; acc[ai][bj][m][1] = xq[q & 1][m][1] + gvv[bj][1] * acc[ai][bj][m][1];
                asm volatile("" : "+v"(acc[ai][bj][m][0]), "+v"(acc[ai][bj][m][1])); }
            asm volatile("" ::: "memory"); }
#undef RX_LOAD
        f32x4 mulv[2][2], shv[2][2];
#pragma unroll
        for (int bj = 0; bj < 2; ++bj) { const int col = col0 + bj * HALF;
            mulv[bj][0] = *(const f32x4*)(g + col) * (*(const f32x4*)(sc + (size_t)b * NMOD + col) + 1.0f); mulv[bj][1] = *(const f32x4*)(g + col + 4) * (*(const f32x4*)(sc + (size_t)b * NMOD + col + 4) + 1.0f);
            shv[bj][0] = *(const f32x4*)(sh + (size_t)b * NMOD + col); shv[bj][1] = *(const f32x4*)(sh + (size_t)b * NMOD + col + 4); }
        st.run(acc, u, wr, wc, fr, fq, lds + 131072, [&]() {
#pragma unroll
            for (int bj = 0; bj < 2; ++bj)
#pragma unroll
                for (int ai = 0; ai < 2; ++ai)
#pragma unroll
                    for (int m = 0; m < 4; ++m) { const f32x4 xa = acc[ai][bj][m][0], xb = acc[ai][bj][m][1];
                        u32x4 xw; xw.x = cvt_pk_bf16(xa[0], xa[1]); xw.y = cvt_pk_bf16(xa[2], xa[3]); xw.z = cvt_pk_bf16(xb[0], xb[1]); xw.w = cvt_pk_bf16(xb[2], xb[3]);
                        *(u32x4*)(X1B + prow(u.pm * BM + ai * HALF + wr * 64 + m * 16 + fr) + (unsigned)(col0 + bj * HALF)) = xw; } });
        const LAS float* S = (const LAS float*)(lds + 131072 + 4096);
        float rsv[2][4];
#pragma unroll
        for (int ai = 0; ai < 2; ++ai)
#pragma unroll
            for (int m = 0; m < 4; ++m) rsv[ai][m] = S[ai * HALF + wr * 64 + m * 16 + fr];
#pragma unroll
        for (int bj = 0; bj < 2; ++bj) { const int col = col0 + bj * HALF;
            const f32x4 mul0 = mulv[bj][0], mul1 = mulv[bj][1], sh0 = shv[bj][0], sh1 = shv[bj][1];
#pragma unroll
            for (int ai = 0; ai < 2; ++ai)
#pragma unroll
                for (int m = 0; m < 4; ++m) { const int r = ai * HALF + wr * 64 + m * 16 + fr; const float rs = rsv[ai][m];
                    const f32x4 xa = acc[ai][bj][m][0], xb = acc[ai][bj][m][1];
                    const f32x4 ha = xa * rs * mul0 + sh0, hb = xb * rs * mul1 + sh1;
                    u32x4 w; w.x = cvt_pk_bf16(ha[0], ha[1]); w.y = cvt_pk_bf16(ha[2], ha[3]); w.z = cvt_pk_bf16(hb[0], hb[1]); w.w = cvt_pk_bf16(hb[2], hb[3]);
                    *(u32x4*)(HN + (unsigned)(u.pm * BM + r) * 1024u + (unsigned)col) = w; } }
    }
};
struct EpiResFinal {
    static constexpr bool PERM = true, CC = false;
    __device__ __forceinline__ void prefetch(const Unit&, LAS unsigned char*, int) const {}
    const bf16_t* base; float* out; const float* gate; const float* g; RmsStats st; int dostore;
    __device__ __forceinline__ bool zero_after(const Unit&) const { return true; }
    __device__ __forceinline__ void init(f32x4 (&acc)[2][2][4][2], const Unit&, int, int) const {
#pragma unroll
        for (int a = 0; a < 2; ++a)
#pragma unroll
            for (int b = 0; b < 2; ++b)
#pragma unroll
                for (int m = 0; m < 4; ++m)
#pragma unroll
                    for (int n = 0; n < 2; ++n) acc[a][b][m][n] = (f32x4){0.f, 0.f, 0.f, 0.f}; }
    __device__ __forceinline__ void operator()(f32x4 (&acc)[2][2][4][2], const Unit& u, int wr, int wc, int fr, int fq, LAS unsigned char* lds) const {
        const int row0 = u.pm * BM + wr * 64 + fr, col0 = u.pn * BM + wc * 32 + 8 * fq; const int b = u.pm >> 4;
        u32x4 xw[2][2][4];
#pragma unroll
        for (int bj = 0; bj < 2; ++bj)
#pragma unroll
            for (int ai = 0; ai < 2; ++ai)
#pragma unroll
                for (int m = 0; m < 4; ++m) xw[bj][ai][m] = *(const u32x4*)(base + prow(row0 + ai * HALF + m * 16) + (unsigned)(col0 + bj * HALF));
#pragma unroll
        for (int bj = 0; bj < 2; ++bj) { const f32x4 gv0 = *(const f32x4*)(gate + (size_t)b * NMOD + col0 + bj * HALF), gv1 = *(const f32x4*)(gate + (size_t)b * NMOD + col0 + bj * HALF + 4);
#pragma unroll
            for (int ai = 0; ai < 2; ++ai)
#pragma unroll
                for (int m = 0; m < 4; ++m) { const u32x4 x = xw[bj][ai][m];
                    acc[ai][bj][m][0] = (f32x4){bflo(x.x), bfhi(x.x), bflo(x.y), bfhi(x.y)} + gv0 * acc[ai][bj][m][0];
                    acc[ai][bj][m][1] = (f32x4){bflo(x.z), bfhi(x.z), bflo(x.w), bfhi(x.w)} + gv1 * acc[ai][bj][m][1];
                    asm volatile("" : "+v"(acc[ai][bj][m][0]), "+v"(acc[ai][bj][m][1])); } }
        f32x4 ggv[2][2];
#pragma unroll
        for (int bj = 0; bj < 2; ++bj) { ggv[bj][0] = *(const f32x4*)(g + col0 + bj * HALF); ggv[bj][1] = *(const f32x4*)(g + col0 + bj * HALF + 4); }
        st.run(acc, u, wr, wc, fr, fq, lds + 131072);
        const LAS float* S = (const LAS float*)(lds + 131072 + 4096);
        float rsv[2][4];
#pragma unroll
        for (int ai = 0; ai < 2; ++ai)
#pragma unroll
            for (int m = 0; m < 4; ++m) rsv[ai][m] = S[ai * HALF + wr * 64 + m * 16 + fr];
#pragma unroll
        for (int bj = 0; bj < 2; ++bj) { const int col = col0 + bj * HALF; const f32x4 gg0 = ggv[bj][0], gg1 = ggv[bj][1];
#pragma unroll
            for (int ai = 0; ai < 2; ++ai)
#pragma unroll
                for (int m = 0; m < 4; ++m) { const int r = ai * HALF + wr * 64 + m * 16 + fr; const float rs = rsv[ai][m];
                    const f32x4 o0 = acc[ai][bj][m][0] * rs * gg0, o1 = acc[ai][bj][m][1] * rs * gg1; float* op = out + (unsigned)(u.pm * BM + r) * 1024u + (unsigned)col;
                    if (dostore) { __builtin_nontemporal_store(o0, (f32x4*)op); __builtin_nontemporal_store(o1, (f32x4*)(op + 4)); } else asm volatile("" :: "v"(o0), "v"(o1)); } }
    }
};
struct EpiUp {
    static constexpr bool PERM = true, CC = true;
    __device__ __forceinline__ void prefetch(const Unit&, LAS unsigned char*, int) const {}
    bf16_t* O;
    __device__ __forceinline__ bool zero_after(const Unit&) const { return true; }
    __device__ __forceinline__ void init(f32x4 (&acc)[2][2][4][2], const Unit&, int, int) const {
#pragma unroll
        for (int a = 0; a < 2; ++a)
#pragma unroll
            for (int b = 0; b < 2; ++b)
#pragma unroll
                for (int m = 0; m < 4; ++m)
#pragma unroll
                    for (int n = 0; n < 2; ++n) acc[a][b][m][n] = (f32x4){0.f, 0.f, 0.f, 0.f}; }
    __device__ __forceinline__ void operator()(f32x4 (&acc)[2][2][4][2], const Unit& u, int wr, int wc, int fr, int fq, LAS unsigned char*) const {
        const int row0 = u.pm * BM + wr * 64 + fr, col0 = u.pn * BM + wc * 64 + 8 * fq;
#pragma unroll
        for (int ai = 0; ai < 2; ++ai)
#pragma unroll
            for (int m = 0; m < 4; ++m) { bf16_t* rowp = O + (size_t)u.pm * PANEL_ELEMS + (size_t)(wr * 64 + fr + ai * HALF + m * 16) * FF + col0;
#pragma unroll
                for (int bj = 0; bj < 2; ++bj) { f32x4 v0 = acc[ai][bj][m][0], v1 = acc[ai][bj][m][1];
#pragma unroll
                    for (int e = 0; e < 4; ++e) { v0[e] = vmax1(v0[e], 0.f); v1[e] = vmax1(v1[e], 0.f); }
                    v0 = v0 * v0; v1 = v1 * v1;
                    u32x4 w; w.x = cvt_pk_bf16(v0[0], v0[1]); w.y = cvt_pk_bf16(v0[2], v0[3]); w.z = cvt_pk_bf16(v1[0], v1[1]); w.w = cvt_pk_bf16(v1[2], v1[3]);
                    *(u32x4*)(rowp + bj * 32) = w; } }
    }
};
}

struct Args { const float* in[23]; float* out; unsigned char* ws; };

__device__ __forceinline__ void transpose_item(const float* W, int ld, int k0, int n0, bf16_t* WT, int row_base, int ldo, LAS float* scr, int lane, float mulc = 1.0f) {
    f32x4 tv[8];
    const int r8 = lane >> 3, c4 = (lane & 7) * 4;
#pragma unroll
    for (int i = 0; i < 8; ++i) tv[i] = __builtin_nontemporal_load((const f32x4*)(W + (size_t)(k0 + 8 * i + r8) * ld + n0 + c4));
#pragma unroll
    for (int i = 0; i < 8; ++i) { LAS float* d = scr + (8 * i + r8) * 33 + c4; d[0] = tv[i].x * mulc; d[1] = tv[i].y * mulc; d[2] = tv[i].z * mulc; d[3] = tv[i].w * mulc; }
    LDS_WAIT(); asm volatile("" ::: "memory");
    const int c = lane & 7;
#pragma unroll
    for (int j = 0; j < 4; ++j) { const int n = (lane >> 3) + 8 * j; const LAS float* s = scr + (8 * c) * 33 + n;
        u32x4 o; o.x = pk2(s[0 * 33], s[1 * 33]); o.y = pk2(s[2 * 33], s[3 * 33]); o.z = pk2(s[4 * 33], s[5 * 33]); o.w = pk2(s[6 * 33], s[7 * 33]);
        *(u32x4*)(WT + (size_t)(row_base + n) * ldo + k0 + 8 * c) = o; }
    LDS_WAIT(); asm volatile("" ::: "memory");
}

__device__ __forceinline__ void norm_row_to_bf16(const float* xrow, bf16_t* orow, const LAS float* tab, int lane) {
    const f32x4* xr = (const f32x4*)xrow + lane;
    f32x4 v[4]; float s = 0.f;
#pragma unroll
    for (int j = 0; j < 4; ++j) { v[j] = xr[64 * j]; s += (v[j].x * v[j].x + v[j].y * v[j].y) + (v[j].z * v[j].z + v[j].w * v[j].w); }
    const float rstd = 1.0f / sqrtf(wave_sum(s) * (1.f / D) + EPS);
    unsigned long long* o8 = (unsigned long long*)orow + lane;
#pragma unroll
    for (int j = 0; j < 4; ++j) { const f32x4 sc = *(const LAS f32x4*)(tab + 4 * lane + 256 * j), sh = *(const LAS f32x4*)(tab + 1024 + 4 * lane + 256 * j);
        const f32x4 h = v[j] * rstd * sc + sh;
        o8[64 * j] = (unsigned long long)pk2(h.x, h.y) | ((unsigned long long)pk2(h.z, h.w) << 32); }
}

__device__ __forceinline__ void norm_row2_to_bf16(const float* xa, bf16_t* oa, const LAS float* ta, const float* xb, bf16_t* ob, const LAS float* tb, int lane) {
    const f32x4* pa = (const f32x4*)xa + 2 * lane; const f32x4* pb = (const f32x4*)xb + 2 * lane;
    f32x4 va[4], vb[4]; float sa = 0.f, sb = 0.f;
#pragma unroll
    for (int j = 0; j < 2; ++j) { va[2 * j] = __builtin_nontemporal_load(pa + 128 * j); va[2 * j + 1] = __builtin_nontemporal_load(pa + 128 * j + 1);
                                  vb[2 * j] = __builtin_nontemporal_load(pb + 128 * j); vb[2 * j + 1] = __builtin_nontemporal_load(pb + 128 * j + 1); }
#pragma unroll
    for (int j = 0; j < 4; ++j) { sa += (va[j].x * va[j].x + va[j].y * va[j].y) + (va[j].z * va[j].z + va[j].w * va[j].w); sb += (vb[j].x * vb[j].x + vb[j].y * vb[j].y) + (vb[j].z * vb[j].z + vb[j].w * vb[j].w); }
    const float ra = 1.0f / sqrtf(wave_sum(sa) * (1.f / D) + EPS), rb = 1.0f / sqrtf(wave_sum(sb) * (1.f / D) + EPS);
    u32x4* qa = (u32x4*)oa + lane; u32x4* qb = (u32x4*)ob + lane;
#pragma unroll
    for (int j = 0; j < 2; ++j) { const LAS float* t = ta + 512 * j + 8 * lane;
        const f32x4 h0 = va[2 * j] * ra * *(const LAS f32x4*)t + *(const LAS f32x4*)(t + 1024), h1 = va[2 * j + 1] * ra * *(const LAS f32x4*)(t + 4) + *(const LAS f32x4*)(t + 1028);
        u32x4 w; w.x = pk2(h0.x, h0.y); w.y = pk2(h0.z, h0.w); w.z = pk2(h1.x, h1.y); w.w = pk2(h1.z, h1.w); qa[64 * j] = w; }
#pragma unroll
    for (int j = 0; j < 2; ++j) { const LAS float* t = tb + 512 * j + 8 * lane;
        const f32x4 h0 = vb[2 * j] * rb * *(const LAS f32x4*)t + *(const LAS f32x4*)(t + 1024), h1 = vb[2 * j + 1] * rb * *(const LAS f32x4*)(t + 4) + *(const LAS f32x4*)(t + 1028);
        u32x4 w; w.x = pk2(h0.x, h0.y); w.y = pk2(h0.z, h0.w); w.z = pk2(h1.x, h1.y); w.w = pk2(h1.z, h1.w); qb[64 * j] = w; }
}

__global__ void __launch_bounds__(NWAVES * 64, 2) fwd_kernel(Args args) {
    extern __shared__ __attribute__((aligned(16))) unsigned char lds_raw[];
    LAS unsigned char* lds = (LAS unsigned char*)lds_raw;
    volatile LAS unsigned* MISC = (volatile LAS unsigned*)(lds + MISC_OFF);
    int tid, lane, wave, gw, gtid;
    const int G = gridDim.x, bx = blockIdx.x;
    const int vcu = (G % 8 == 0) ? (bx % 8) * (G / 8) + bx / 8 : bx;
    const int NGW = G * NWAVES, NGT = G * NWAVES * 64;
    wave = __builtin_amdgcn_readfirstlane((int)threadIdx.x >> 6);
#define REFRESH() do { tid = tid_from_wave(wave); lane = tid & 63; gw = vcu * NWAVES + wave; gtid = bx * (NWAVES * 64) + tid; } while (0)
    REFRESH();
    unsigned char* ws = args.ws;
    for (int u = tid; u < (LDS_BYTES - LDSCTL_OFF) / 4; u += NWAVES * 64) ((LAS unsigned*)(lds + LDSCTL_OFF))[u] = 0u;
    __syncthreads();
    gu32* ctl = (gu32*)(ws + WS_CTL);
    XcdBarrier bar = xcd_barrier_post(g_sync, MISC + 8);
    for (int w = gtid; w < CW_XCC; w += G * NWAVES * 64) ctl[w] = 0u;
    if (bx == 0 && tid < 64) ctl[CW_WRDY + tid] = 0u;
    if (threadIdx.x == 0) __hip_atomic_store((unsigned*)(ctl + CW_XCC) + bx, xb_xcc_id() + 1u, __ATOMIC_RELAXED, __HIP_MEMORY_SCOPE_AGENT);
    const bool teams = (G == 256);
    TeamBar tbar{(unsigned*)(ctl + CW_TEAM) + 64 * (8 * (bx & 7) + ((bx >> 3) & 7)), MISC + 12, (unsigned*)(ctl + CW_TMO)};

    const float* x = args.in[0]; const float* cvec = args.in[1]; const float* g_mix = args.in[2]; const float* g_mlp = args.in[3];
    const float* w_ada = args.in[4]; const float* b_ada = args.in[5]; const float* w_in = args.in[6]; const float* conv_w = args.in[7]; const float* conv_b = args.in[8];
    const float* w_rg_a = args.in[9]; const float* b_rg_a = args.in[10]; const float* w_rg_x = args.in[11]; const float* b_rg_x = args.in[12]; const float* a_param = args.in[13];
    const float* w_br_a = args.in[14]; const float* w_pool = args.in[15]; const float* b_pool = args.in[16]; const float* pool_scale = args.in[17]; const float* w_br_b = args.in[18];
    const float* w_out = args.in[19]; const float* w_up = args.in[20]; const float* w_down = args.in[21]; const float* final_g = args.in[22];
    float* out = args.out;
    float* MODP = (float*)(ws + WS_MODP); float* MODF = (float*)(ws + WS_MODF); float* SPT = (float*)(ws + WS_SPT);
    bf16_t* WIN = (bf16_t*)(ws + WS_WIN); bf16_t* WA = (bf16_t*)(ws + WS_WA); bf16_t* WB = (bf16_t*)(ws + WS_WB); bf16_t* WO = (bf16_t*)(ws + WS_WO);
    bf16_t* WUP = (bf16_t*)(ws + WS_WUP); bf16_t* WDN = (bf16_t*)(ws + WS_WDN); bf16_t* WG = (bf16_t*)(ws + WS_WG);
    bf16_t* HB = (bf16_t*)(ws + WS_H); bf16_t* XB = (bf16_t*)(ws + WS_X); bf16_t* YB = XB + PBUF_ELEMS; bf16_t* VB = XB + 2 * PBUF_ELEMS;
    bf16_t* GAB = XB + 3 * PBUF_ELEMS; bf16_t* GBB = XB + 4 * PBUF_ELEMS; bf16_t* FFB = XB;

    for (int full_ = 0; full_ < REP_ALL; ++full_) {
    if (full_ > 0) {
        xcd_barrier(bar); REFRESH();
        for (int w = gtid; w < CW_XCC; w += G * NWAVES * 64) ctl[w] = 0u;
        if (bx == 0 && tid < 64) ctl[CW_WRDY + tid] = 0u;
        if (bx == 0 && tid == 0) { __hip_atomic_store(g_sync + GB_MOD, 0u, __ATOMIC_RELAXED, __HIP_MEMORY_SCOPE_AGENT); __hip_atomic_store(g_sync + GB_READY, 0u, __ATOMIC_RELAXED, __HIP_MEMORY_SCOPE_AGENT); }
        xcd_barrier(bar); REFRESH();
    }
    for (int vb = vcu; vb < 192; vb += G) {
        const int cg = vb % 96, kh = vb / 96, n = cg * 64 + lane, k0 = kh * 512 + wave * 64;
        float ca[4];
#pragma unroll
        for (int b = 0; b < 4; ++b) { const float c = cvec[b * D + k0 + lane]; ca[b] = c * sigmoidf_(c); }
        float acc4[4] = {0.f, 0.f, 0.f, 0.f};
        float wv[64];
#pragma unroll
        for (int r = 0; r < 64; ++r) wv[r] = __builtin_nontemporal_load(w_ada + (size_t)(k0 + r) * NMOD + n);
        asm volatile("" ::: "memory");
#pragma unroll
        for (int r = 0; r < 64; ++r) {
#pragma unroll
            for (int b = 0; b < 4; ++b) acc4[b] += __uint_as_float(__builtin_amdgcn_readlane(__float_as_uint(ca[b]), r)) * wv[r]; }
        LAS float* red = (LAS float*)lds;
#pragma unroll
        for (int b = 0; b < 4; ++b) red[(wave * 4 + b) * 64 + lane] = acc4[b];
        __syncthreads();
        if (tid < 256) { const int b = tid >> 6, l = tid & 63; float s = 0.f;
#pragma unroll
            for (int w = 0; w < 8; ++w) s += red[(w * 4 + b) * 64 + l];
            if (kh == 0) s += b_ada[cg * 64 + l];
            __hip_atomic_store(MODP + (size_t)(kh * 4 + b) * NMOD + cg * 64 + l, s, __ATOMIC_RELAXED, __HIP_MEMORY_SCOPE_AGENT); }
        asm volatile("s_waitcnt vmcnt(0)" ::: "memory");
        __syncthreads();
        if (tid == 0) __hip_atomic_fetch_add(g_sync + GB_MOD, 1u, __ATOMIC_RELAXED, __HIP_MEMORY_SCOPE_AGENT);
    }

    for (int rep_ = 0; rep_ < REP_P1; ++rep_) {
        for (int ra_ = 0; ra_ < REP_P1A; ++ra_)
        for (int tile = vcu; tile < 256; tile += G) {
            const int k0 = (tile >> 4) * 64, n0 = (tile & 15) * 64, g = n0 >> 8, np0 = n0 & 255;
            LAS float* As = (LAS float*)lds;
            LAS float* Bs = (LAS float*)(lds + 65792);
            { f32x4 va[8], vb[8];
#pragma unroll
              for (int j = 0; j < 8; ++j) { const int row = wave * 8 + j; va[j] = *(const f32x4*)(w_in + (size_t)(k0 + row) * DIN + 2048 + 256 * g + lane * 4);
                  const int i = (wave * 8 + j) * 4 + (lane >> 4); vb[j] = *(const f32x4*)(w_pool + (size_t)g * 65536 + (size_t)i * 256 + np0 + (lane & 15) * 4); }
#pragma unroll
              for (int j = 0; j < 8; ++j) { const int row = wave * 8 + j; LAS float* d = As + row * 257 + lane * 4; d[0] = va[j].x; d[1] = va[j].y; d[2] = va[j].z; d[3] = va[j].w;
                  const int i = (wave * 8 + j) * 4 + (lane >> 4); *(LAS f32x4*)(Bs + i * 64 + (lane & 15) * 4) = vb[j]; } }
            __syncthreads();
            const int kh = wave & 1, nh = (wave >> 1) & 1, ih = wave >> 2;
            f32x16 cacc;
#pragma unroll
            for (int r = 0; r < 16; ++r) cacc[r] = 0.f;
            const LAS float* ap = As + (32 * kh + (lane & 31)) * 257 + 128 * ih + (lane >> 5);
            const LAS float* bp = Bs + (128 * ih + (lane >> 5)) * 64 + 32 * nh + (lane & 31);
#pragma unroll 8
            for (int st = 0; st < 64; ++st) cacc = __builtin_amdgcn_mfma_f32_32x32x2f32(ap[2 * st], bp[2 * st * 64], cacc, 0, 0, 0);
            __syncthreads();
            LAS float* red = (LAS float*)lds;
            if (ih == 1) {
#pragma unroll
                for (int r = 0; r < 16; ++r) red[((wave & 3) * 16 + r) * 64 + lane] = cacc[r]; }
            __syncthreads();
            if (ih == 0) {
#pragma unroll
                for (int r = 0; r < 16; ++r) cacc[r] += red[((wave & 3) * 16 + r) * 64 + lane];
                bf16_t* wrow = WIN + (size_t)(2048 + n0 + 32 * nh + (lane & 31)) * 1024 + k0 + 32 * kh + 4 * (lane >> 5);
#pragma unroll
                for (int q = 0; q < 4; ++q) { u32x2 w; w.x = pk2(cacc[4 * q], cacc[4 * q + 1]); w.y = pk2(cacc[4 * q + 2], cacc[4 * q + 3]); *(u32x2*)(wrow + 8 * q) = w; }
            }
            __syncthreads();
        }
#define TRANSPOSE_ITEMS(first_, last_, start_, stride_) do { LAS float* scr = (LAS float*)(lds + wave * 16384); \
            constexpr int I_IN = 16 * 64, I_SQ = 16 * 32, I_UP = 16 * 128, I_DN = 64 * 32, I_G = 4 * 4 * 8; \
            for (int it = (first_) + (start_); it < (last_); it += (stride_)) { int r = it; \
                if (r < I_IN) { const int kb = r / 64, nb = r % 64; transpose_item(w_in, DIN, 64 * kb, 32 * nb, WIN, 32 * nb, 1024, scr, lane); continue; } r -= I_IN; \
                if (r < I_IN) { const int kb = r / 64, nb = r % 64; transpose_item(w_in, DIN, 64 * kb, 3072 + 32 * nb, WIN, 3072 + 32 * nb, 1024, scr, lane); continue; } r -= I_IN; \
                if (r < I_SQ) { const int kb = r / 32, nb = r % 32; transpose_item(w_br_a, D, 64 * kb, 32 * nb, WA, 32 * nb, 1024, scr, lane); continue; } r -= I_SQ; \
                if (r < I_SQ) { const int kb = r / 32, nb = r % 32; transpose_item(w_br_b, D, 64 * kb, 32 * nb, WB, 32 * nb, 1024, scr, lane); continue; } r -= I_SQ; \
                if (r < I_SQ) { const int kb = r / 32, nb = r % 32; transpose_item(w_out, D, 64 * kb, 32 * nb, WO, 32 * nb, 1024, scr, lane); continue; } r -= I_SQ; \
                if (r < I_UP) { const int kb = r / 128, nb = r % 128; transpose_item(w_up, FF, 64 * kb, 32 * nb, WUP, 32 * nb, 1024, scr, lane); continue; } r -= I_UP; \
                if (r < I_DN) { const int kb = r / 32, nb = r % 32; transpose_item(w_down, D, 64 * kb, 32 * nb, WDN, 32 * nb, 4096, scr, lane); continue; } r -= I_DN; \
                { const int gate = r / I_G; r -= gate * I_G; const int g = r / 32, q = r % 32, kb = q / 8, nb = q % 8, j0 = 32 * nb; \
                  const int row_base = (g * 2 + (j0 >> 7)) * 256 + gate * 128 + (j0 & 127); \
                  transpose_item((gate ? w_rg_x : w_rg_a) + (size_t)g * 65536, 256, 64 * kb, j0, WG, row_base, 256, scr, lane, -1.44269504089f); } } } while (0)
        for (int rb2_ = 0; rb2_ < REP_P1B; ++rb2_) { TRANSPOSE_ITEMS(0, teams ? N_WIN_ITEMS : N_ALL_ITEMS, gw, NGW); }
        __syncthreads();
        for (int rc_ = 0; rc_ < REP_P1C; ++rc_) {
            LAS float* tab = (LAS float*)lds;
            if (tid == 0) { unsigned sp = 0u;
                while (__hip_atomic_load(g_sync + GB_MOD, __ATOMIC_RELAXED, __HIP_MEMORY_SCOPE_AGENT) < 192u) { __builtin_amdgcn_s_sleep(2); if (++sp > (1u << 22)) { atomicAdd((unsigned*)(ctl + CW_TMO), 1u); break; } }
                __builtin_amdgcn_fence(__ATOMIC_ACQUIRE, "agent"); asm volatile("s_waitcnt vmcnt(0)" ::: "memory"); }
            __syncthreads();
            const int pmT = 8 * (bx & 7) + ((bx >> 3) & 7);
#define MODP_LD(i_) __hip_atomic_load(MODP + (i_), __ATOMIC_RELAXED, __HIP_MEMORY_SCOPE_AGENT)
            if (teams) {
                const int b = pmT >> 4; float pv[2][4], gm[2];
#pragma unroll
                for (int it = 0; it < 2; ++it) { const int c = tid + 512 * it; gm[it] = g_mix[c];
                    pv[it][0] = MODP_LD((size_t)b * NMOD + c); pv[it][1] = MODP_LD((size_t)(4 + b) * NMOD + c); pv[it][2] = MODP_LD((size_t)b * NMOD + 1024 + c); pv[it][3] = MODP_LD((size_t)(4 + b) * NMOD + 1024 + c); }
#pragma unroll
                for (int it = 0; it < 2; ++it) { const int c = tid + 512 * it; tab[c] = gm[it] * (1.0f + (pv[it][2] + pv[it][3])); tab[1024 + c] = pv[it][0] + pv[it][1]; }
            } else
            for (int idx = tid; idx < 4 * 1024; idx += 512) { const int b = idx >> 10, c = idx & 1023, tb = b;
                const float sh = MODP_LD((size_t)b * NMOD + c) + MODP_LD((size_t)(4 + b) * NMOD + c), sc = MODP_LD((size_t)b * NMOD + 1024 + c) + MODP_LD((size_t)(4 + b) * NMOD + 1024 + c);
                tab[tb * 2048 + c] = g_mix[c] * (1.0f + sc); tab[tb * 2048 + 1024 + c] = sh; }
            for (int idx = gtid; idx < 4 * NMOD; idx += NGT) MODF[idx] = MODP_LD(idx) + MODP_LD(4 * NMOD + idx);
#undef MODP_LD
            if (gtid < 1024) { const float p = a_param[gtid]; SPT[gtid] = -8.0f * 1.44269504089f * (p > 20.f ? p : log1pf(expf(p))); }
            if (tid == 0) MISC[15] = 0u;
            asm volatile("s_waitcnt vmcnt(0)" ::: "memory");
            __syncthreads();
            if (teams && rc_ == 0 && rep_ == 0 && tid == 0) {
                __builtin_amdgcn_fence(__ATOMIC_RELEASE, "agent"); asm volatile("s_waitcnt vmcnt(0)" ::: "memory");
                __hip_atomic_fetch_add(g_sync + GB_READY, 1u, __ATOMIC_RELAXED, __HIP_MEMORY_SCOPE_AGENT); }
            if (teams) { const int r0 = pmT * 256 + (bx >> 6) * 64;
                for (;;) { unsigned p = 0u; if (lane == 0) p = __hip_atomic_fetch_add((LAS unsigned*)(lds + MISC_OFF) + 15, 1u, __ATOMIC_RELAXED, __HIP_MEMORY_SCOPE_WORKGROUP);
                    p = (unsigned)__builtin_amdgcn_readfirstlane((int)p); if (p >= 32u) break;
                    norm_row2_to_bf16(x + (size_t)(r0 + p) * D, HB + (size_t)(r0 + p) * D, tab, x + (size_t)(r0 + 32 + p) * D, HB + (size_t)(r0 + 32 + p) * D, tab, lane); } }
            else for (int m = gw; m < M; m += 2 * NGW) norm_row2_to_bf16(x + (size_t)m * D, HB + (size_t)m * D, tab + (m >> 12) * 2048, x + (size_t)(m + NGW) * D, HB + (size_t)(m + NGW) * D, tab + ((m + NGW) >> 12) * 2048, lane);
            __syncthreads();
        }
    }
    if (teams) { if (threadIdx.x == 0) { unsigned sp = 0u;
            while (__hip_atomic_load(g_sync + GB_READY, __ATOMIC_RELAXED, __HIP_MEMORY_SCOPE_AGENT) < (unsigned)G) { __builtin_amdgcn_s_sleep(2); if (++sp > (1u << 22)) { atomicAdd((unsigned*)(ctl + CW_TMO), 1u); break; } } } }
    else { for (int rb_ = 0; rb_ < REP_BAR; ++rb_) xcd_barrier(bar); }
    REFRESH();

#define RESET_SYNC_WORDS() do { for (int j_ = 0; j_ < 16; ++j_) { g_sync[XB_XCNT(j_)] = 0u; g_sync[XB_XSUB(j_)] = 0u; g_sync[XB_XGEN(j_)] = 0u; } \
        g_sync[XB_TOP] = 0u; g_sync[XB_TOPGEN] = 0u; g_sync[XB_TMO] = 0u; g_sync[GB_MOD] = 0u; g_sync[GB_READY] = 0u; g_sync[GB_DEPART] = 0u; } while (0)
    if (wave == 0) {
        const unsigned dep = (teams && REP_ALL == 1 && lane == 0) ? xb_add(g_sync + GB_DEPART, 1u) : 0u;
        unsigned v = 0u;
        if (lane < 8) { const int pmn = 8 * (bx & 7) + ((bx >> 3) & 7) + 1, k = lane & 3;
            v = __hip_atomic_load((unsigned*)(ctl + CW_XCC) + (lane < 4 ? (bx & 63) + 64 * k : ((pmn >> 3) & 7) + 8 * ((pmn & 7) + 8 * k)), __ATOMIC_RELAXED, __HIP_MEMORY_SCOPE_AGENT); }
        const unsigned mine = (unsigned)__builtin_amdgcn_readlane((int)v, bx >> 6);
        const unsigned long long okm = __ballot(lane < 8 && v == mine && v != 0u);
        const unsigned sm = (okm & 0xFull) == 0xFull ? 1u : 0u, sn = (okm & 0xFFull) == 0xFFull ? 1u : 0u;
        if (lane == 0) { MISC[12] = teams ? sm : 0u; MISC[13] = teams ? sn : 0u; }
        if (teams && REP_ALL == 1 && lane == 0 && dep + 1u == (unsigned)G) RESET_SYNC_WORDS(); }
    __syncthreads();
    if (teams) { team_arrive(tbar); REFRESH(); }
    if (teams && (((bx & 7) >> 1) & 1)) {
        const int bidx = (((bx & 7) >> 2) * 2 + (bx & 1)) * 32 + (bx >> 3);
        TRANSPOSE_ITEMS(N_WIN_ITEMS, N_ALL_ITEMS, bidx * NWAVES + wave, 128 * NWAVES);
        asm volatile("s_waitcnt vmcnt(0)" ::: "memory");
        __syncthreads();
        REFRESH();
    }
#undef TRANSPOSE_ITEMS
    if (teams) { team_wait(tbar, 4u); REFRESH(); }
    if (STAGGER_TICKS > 0 && teams && (((bx & 7) >> 1) & 1)) {
        const unsigned long long t0_ = __builtin_amdgcn_s_memrealtime(); while (__builtin_amdgcn_s_memrealtime() - t0_ < (unsigned long long)STAGGER_TICKS) __builtin_amdgcn_s_sleep(8); }
    for (int rep_ = 0; rep_ < REP_P2; ++rep_) {
        pg8::Sched S{}; S.nM = M / 256; S.nN = DIN / 256; S.G = G; S.c = bx; S.nseg = 1; S.A[0] = S.A[1] = (const char*)HB; S.B[0] = S.B[1] = (const char*)WIN; S.lda = 1024; S.ldb = 1024; S.acol_mul = 0; S.acol_shift = 0; S.apan[0] = S.apan[1] = 256u * (unsigned)S.lda * 2u;
        pg8::EpiProj E{XB, (size_t)PBUF_ELEMS, (teams && rep_ == 0 && (((bx & 7) >> 1) & 1)) ? (unsigned*)(ctl + CW_WRDY) : nullptr, conv_w, conv_b, (bf16_t*)(ws + WS_XHALO)};
        pg8::gemm_phase<pg8::EpiProj, pg8::Sched, true, true>(lds, S, 1024, E, wave);
    }
    if (teams && threadIdx.x == 0) { unsigned sp = 0u;
        while (__hip_atomic_load((unsigned*)(ctl + CW_WRDY), __ATOMIC_RELAXED, __HIP_MEMORY_SCOPE_AGENT) < 128u) { __builtin_amdgcn_s_sleep(2); if (++sp > (1u << 22)) { atomicAdd((unsigned*)(ctl + CW_TMO), 1u); break; } } }
    if (teams) { const int pm_ = 8 * (bx & 7) + ((bx >> 3) & 7);
        team_barrier(tbar, 8u, (pm_ & 15) != 15 && MISC[13] == 0u, (pm_ & 15) != 0 ? (unsigned*)(ctl + CW_TEAM) + 64 * (pm_ - 1) : nullptr, 8u); }
    else xcd_barrier(bar);
    REFRESH();

    for (int rep_ = 0; rep_ < REP_P3; ++rep_) {
        bf16_t* POOL = (bf16_t*)out;
        for (int p = bx; p < 256; p += G) { const int pm = pg8::pair_pm(p, G), g = pg8::pair_g(p, G);
            if ((pm & 15) != 0 && tid < 96) {
                const bf16_t* XHp = (const bf16_t*)(ws + WS_XHALO); const int r = tid >> 5, c0 = g * 256 + (tid & 31) * 8;
                float a8[8];
                u32x4 xv4[4]; f32x4 wv4[4][2];
#pragma unroll
                for (int j = 0; j < 4; ++j) { const int rr = r - 3 + j;
                    xv4[j] = *(const u32x4*)(XHp + (size_t)(rr < 0 ? (pm - 1) * 6 + 6 + rr : pm * 6 + rr) * 1024 + c0);
                    wv4[j][0] = *(const f32x4*)(conv_w + j * 1024 + c0); wv4[j][1] = *(const f32x4*)(conv_w + j * 1024 + c0 + 4); }
                { const f32x4 b0 = *(const f32x4*)(conv_b + c0), b1 = *(const f32x4*)(conv_b + c0 + 4); a8[0] = b0.x; a8[1] = b0.y; a8[2] = b0.z; a8[3] = b0.w; a8[4] = b1.x; a8[5] = b1.y; a8[6] = b1.z; a8[7] = b1.w; }
                asm volatile("" ::: "memory");
#pragma unroll
                for (int j = 0; j < 4; ++j) {
                    const u32x4 xv = xv4[j];
                    const f32x4 w0 = wv4[j][0], w1 = wv4[j][1];
                    a8[0] += bflo(xv.x) * w0.x; a8[1] += bfhi(xv.x) * w0.y; a8[2] += bflo(xv.y) * w0.z; a8[3] += bfhi(xv.y) * w0.w;
                    a8[4] += bflo(xv.z) * w1.x; a8[5] += bfhi(xv.z) * w1.y; a8[6] += bflo(xv.w) * w1.z; a8[7] += bfhi(xv.w) * w1.w; }
                u32x4 ov; ov.x = cvt_pk_bf16(a8[0], a8[1]); ov.y = cvt_pk_bf16(a8[2], a8[3]); ov.z = cvt_pk_bf16(a8[4], a8[5]); ov.w = cvt_pk_bf16(a8[6], a8[7]);
                *(u32x4*)(XB + prow(pm * 256 + r) + c0) = ov;
            }
        }
        VM_WAIT(); __syncthreads();
        {
            pg8::SchedRnn S{G, bx, (const char*)XB, (const char*)WG, 1024, 256};
            pg8::EpiRnn E{XB, YB, YB, b_rg_a, b_rg_x, SPT, (unsigned long long*)(ws + WS_SUM), (unsigned*)(ctl + CW_RNN), (unsigned*)(ctl + CW_TMO)};
            int Kr = 256; asm volatile("" : "+s"(Kr));
            pg8::gemm_phase<pg8::EpiRnn, pg8::SchedRnn, true, true>(lds, S, Kr, E, wave);
        }
        REFRESH();
        for (int p = bx; p < 256; p += G) { const int pm = pg8::pair_pm(p, G), g = pg8::pair_g(p, G);
            const int c0 = (tid & 127) * 8, W = 2 << (c0 >> 8), m0 = pm * 256 + g * 64 + (tid >> 7) * 16, t0 = m0 & (SEQ - 1);
#define UNPK_LO(v_) ((f32x4){bflo((v_).x), bfhi((v_).x), bflo((v_).y), bfhi((v_).y)})
#define UNPK_HI(v_) ((f32x4){bflo((v_).z), bfhi((v_).z), bflo((v_).w), bfhi((v_).w)})
            f32x4 sA = (f32x4){0.f, 0.f, 0.f, 0.f}, sB = (f32x4){0.f, 0.f, 0.f, 0.f};
#pragma unroll
            for (int hb = 0; hb < 2; ++hb) { u32x4 hv[8];
#pragma unroll
                for (int jj = 0; jj < 8; ++jj) { const int j = 1 + hb * 8 + jj; const bool ok = (j <= W) && (t0 - j >= 0);     const u32x4 v = *(const u32x4*)(VB + prow(ok ? m0 - j : m0) + c0); hv[jj] = ok ? v : (u32x4){0u, 0u, 0u, 0u}; }
#pragma unroll
                for (int jj = 0; jj < 8; ++jj) { const u32x4 v = hv[jj]; sA += UNPK_LO(v); sB += UNPK_HI(v); } }
            const f32x4 bpA = *(const f32x4*)(b_pool + c0), bpB = *(const f32x4*)(b_pool + c0 + 4), psA = *(const f32x4*)(pool_scale + c0), psB = *(const f32x4*)(pool_scale + c0 + 4);
            u32x4 nvb[2][4], ovb[2][4];
#define PL_LOAD(ch_) do { _Pragma("unroll") for (int r = 0; r < 4; ++r) { const int rr = (ch_) * 4 + r; nvb[(ch_) & 1][r] = *(const u32x4*)(VB + prow(m0 + rr) + c0); \
                const bool ok = (t0 + rr - W) >= 0; const u32x4 v = *(const u32x4*)(VB + prow(ok ? m0 + rr - W : m0) + c0); ovb[(ch_) & 1][r] = ok ? v : (u32x4){0u, 0u, 0u, 0u}; } } while (0)
            PL_LOAD(0);
#pragma unroll
            for (int ch = 0; ch < 4; ++ch) {
                if (ch < 3) PL_LOAD(ch + 1);
#pragma unroll
                for (int r = 0; r < 4; ++r) { const int rr = ch * 4 + r, t = t0 + rr; const int cnt = (t + 1 < W) ? t + 1 : W; const float inv = 1.0f / (float)cnt;
                    const f32x4 cA = UNPK_LO(nvb[ch & 1][r]), cB = UNPK_HI(nvb[ch & 1][r]);
                    sA += pk_sub4(cA, UNPK_LO(ovb[ch & 1][r])); sB += pk_sub4(cB, UNPK_HI(ovb[ch & 1][r]));
                    const f32x4 oA = (sA * inv + pk_sub4(bpA, cA)) * psA, oB = (sB * inv + pk_sub4(bpB, cB)) * psB;
                    u32x4 o; o.x = cvt_pk_bf16(oA[0], oA[1]); o.y = cvt_pk_bf16(oA[2], oA[3]); o.z = cvt_pk_bf16(oB[0], oB[1]); o.w = cvt_pk_bf16(oB[2], oB[3]);
                    *(u32x4*)(POOL + pool_row(m0 + rr) + c0) = o; } }
#undef PL_LOAD
#undef UNPK_LO
#undef UNPK_HI
        }
    }
    if (teams) team_barrier(tbar, 12u); else xcd_barrier(bar);
    REFRESH();

    for (int rep_ = 0; rep_ < REP_P6; ++rep_) {
        pg8::Sched S{}; S.nM = M / 256; S.nN = 4; S.G = G; S.c = bx; S.nseg = 2; S.A[0] = (const char*)YB; S.A[1] = (const char*)out; S.B[0] = (const char*)WA; S.B[1] = (const char*)WB; S.lda = 1024; S.ldb = 1024; S.acol_mul = 0; S.acol_shift = 0; S.apan[0] = PANEL_ELEMS * 2u; S.apan[1] = 1048576u;
        pg8::EpiMerge E{GAB, GBB, GAB};
        pg8::gemm_phase<pg8::EpiMerge, pg8::Sched, true, true>(lds, S, 1024, E, wave);
    }
    if (teams) team_barrier(tbar, 16u); else xcd_barrier(bar);
    REFRESH();

    for (int rep_ = 0; rep_ < REP_P7; ++rep_) {
        pg8::Sched S{}; S.nM = M / 256; S.nN = 4; S.G = G; S.c = bx; S.nseg = 1; S.A[0] = S.A[1] = (const char*)GAB; S.B[0] = S.B[1] = (const char*)WO; S.lda = 1024; S.ldb = 1024; S.acol_mul = 0; S.acol_shift = 0; S.apan[0] = S.apan[1] = PANEL_ELEMS * 2u;
        pg8::RmsStats st{(float*)(ws + WS_XCH), (unsigned*)(ctl + CW_PAN), (unsigned*)(ctl + CW_TMO)};
        pg8::EpiResNorm E{x, GBB, HB, MODF + 2048, MODF + 4096, MODF + 3072, g_mlp, st};
        pg8::gemm_phase<pg8::EpiResNorm, pg8::Sched, true, true>(lds, S, 1024, E, wave);
    }
    if (teams) { const int pm_ = 8 * (bx & 7) + ((bx >> 3) & 7);
        team_barrier(tbar, 20u, false, (pm_ & 15) != 15 ? (unsigned*)(ctl + CW_TEAM) + 64 * (pm_ + 1) : nullptr, 12u); }
    else xcd_barrier(bar);
    REFRESH();

    for (int rep_ = 0; rep_ < REP_P9; ++rep_) {
        pg8::Sched S{}; S.nM = M / 256; S.nN = FF / 256; S.G = G; S.c = bx; S.nseg = 1; S.A[0] = S.A[1] = (const char*)HB; S.B[0] = S.B[1] = (const char*)WUP; S.lda = 1024; S.ldb = 1024; S.acol_mul = 0; S.acol_shift = 0; S.apan[0] = S.apan[1] = 256u * (unsigned)S.lda * 2u;
        pg8::EpiUp E{FFB};
        pg8::gemm_phase<pg8::EpiUp, pg8::Sched, true, true>(lds, S, 1024, E, wave);
    }
    if (teams) team_barrier(tbar, 24u); else xcd_barrier(bar);
    REFRESH();

    for (int rep_ = 0; rep_ < REP_P10; ++rep_) {
        pg8::Sched S{}; S.nM = M / 256; S.nN = 4; S.G = G; S.c = bx; S.nseg = 1; S.A[0] = S.A[1] = (const char*)FFB; S.B[0] = S.B[1] = (const char*)WDN; S.lda = 4096; S.ldb = 4096; S.acol_mul = 0; S.acol_shift = 0; S.apan[0] = S.apan[1] = PANEL_ELEMS * 2u;
        pg8::RmsStats st{(float*)(ws + WS_XCH + 256 * 1024), (unsigned*)(ctl + CW_PAN + 64 * 64), (unsigned*)(ctl + CW_TMO)};
        pg8::EpiResFinal E{GBB, out, MODF + 5120, final_g, st, (rep_ + 1 < REP_P10) ? 0 : 1};
        pg8::gemm_phase<pg8::EpiResFinal, pg8::Sched, true, true>(lds, S, 4096, E, wave);
    }
    }
    if ((!teams || REP_ALL > 1) && threadIdx.x == 0) { if (xb_add(g_sync + GB_DEPART, 1u) + 1u == (unsigned)G) RESET_SYNC_WORDS(); }
}

extern "C" void kernel_launch(void* const* d_in, const int* in_sizes, int n_in, void* d_out, int out_size, void* d_ws, size_t ws_size, hipStream_t stream) {
    static int grid = 0;
    if (grid == 0) {
        if (n_in != 23 || in_sizes[0] != M * D || out_size != M * D || ws_size < WS_END) { fprintf(stderr, "kernel_launch: unexpected shapes (n_in %d, in0 %d, out %d, ws %zu); nothing launched\n", n_in, n_in > 0 ? in_sizes[0] : -1, out_size, ws_size); grid = -1; return; }
        int dev = 0, cus = 0, per_cu = 0;
        if (hipGetDevice(&dev) != hipSuccess || hipDeviceGetAttribute(&cus, hipDeviceAttributeMultiprocessorCount, dev) != hipSuccess) { fprintf(stderr, "kernel_launch: device query failed\n"); grid = -1; return; }
        if (hipFuncSetAttribute((const void*)fwd_kernel, hipFuncAttributeMaxDynamicSharedMemorySize, LDS_BYTES) != hipSuccess) { fprintf(stderr, "kernel_launch: hipFuncSetAttribute failed\n"); grid = -1; return; }
        if (hipOccupancyMaxActiveBlocksPerMultiprocessor(&per_cu, (const void*)fwd_kernel, NWAVES * 64, LDS_BYTES) != hipSuccess || per_cu < 1) { fprintf(stderr, "kernel_launch: occupancy query says %d blocks per CU\n", per_cu); (void)hipGetLastError(); grid = -1; return; }
        grid = cus;
    }
    if (grid < 0) return;
    Args a{};
    for (int i = 0; i < 23; ++i) a.in[i] = (const float*)d_in[i];
    a.out = (float*)d_out; a.ws = (unsigned char*)d_ws;
    void* kargs[] = {&a};
    hipError_t e = hipLaunchCooperativeKernel((const void*)fwd_kernel, dim3(grid), dim3(NWAVES * 64), kargs, LDS_BYTES, stream);
    if (e != hipSuccess) fprintf(stderr, "kernel_launch: cooperative launch failed: %s (grid %d)\n", hipGetErrorString(e), grid);
}
```
